# Optimizing an MI355X kernel written in HIP

```python
import jax, jax.numpy as jnp
from jax import lax
import numpy as np

D_MODEL = 1024
BATCH = 16
SEQ = 4096
DEPTH = 2

CTX_LEN = 256
GRID_W = 64
GLA_HEADS = 4
GLA_DK = 64
GLA_DV = 128
GLA_KW = GLA_HEADS * GLA_DK
GLA_VW = GLA_HEADS * GLA_DV
DECAY_RANK = 16
GATE_NORMALIZER = 16.0
CHUNK = 64
CONV_CH = D_MODEL - GLA_VW
CONV_K = 3
MIX_W = GLA_VW + CONV_CH
PROJ_SIZES = (GLA_KW, GLA_KW, GLA_VW, GLA_VW, DECAY_RANK, DECAY_RANK, CONV_CH, CONV_CH, CONV_CH)
PROJ_W = sum(PROJ_SIZES)
D_FF = 2816
N_EXPERTS = 8
TOP_K = 2
D_FF_EXPERT = 3584
N_DENSE = (DEPTH + 1) // 2
N_MOE = DEPTH // 2
EPS = 1e-6

kernel_name = "hybrid_gla_shortconv_moe_dit"


def rmsnorm(x, g):
    xf = x.astype(jnp.float32)
    y = xf * lax.rsqrt(jnp.mean(xf * xf, axis=-1, keepdims=True) + EPS)
    return (y * g.astype(jnp.float32)).astype(x.dtype)


def modulate(x, shift, scale):
    return x * (1 + scale) + shift


def split_proj(p):
    idx = [int(v) for v in np.cumsum(PROJ_SIZES)[:-1]]
    return jnp.split(p, idx, axis=-1)


def to_heads(t, dh):
    b, l, w = t.shape
    return t.reshape(b, l, w // dh, dh).transpose(0, 2, 1, 3)


def gla_chunk_scan(q, k, v, log_a, s0):
    b_, h_, l_, dk = q.shape
    dv = v.shape[-1]
    nc = l_ // CHUNK

    def to_chunks(t):
        return t.reshape(b_, h_, nc, CHUNK, t.shape[-1]).transpose(2, 0, 1, 3, 4)

    tril = jnp.tril(jnp.ones((CHUNK, CHUNK), dtype=bool))

    def step(s, inp):
        qc, kc, vc, gc = [t.astype(jnp.float32) for t in inp]
        bcum = jnp.cumsum(gc, axis=-2)
        o_inter = jnp.einsum('bhcd,bhde->bhce', qc * jnp.exp(bcum), s)
        diff = bcum[:, :, :, None, :] - bcum[:, :, None, :, :]
        decay = jnp.exp(jnp.where(tril[:, :, None], diff, -jnp.inf))
        attn = jnp.einsum('bhid,bhijd->bhij', qc, decay * kc[:, :, None, :, :])
        o_intra = jnp.einsum('bhij,bhje->bhie', attn, vc)
        b_last = bcum[:, :, -1, :]
        s_new = jnp.exp(b_last)[..., None] * s + jnp.einsum(
            'bhjd,bhje->bhde', kc * jnp.exp(b_last[:, :, None, :] - bcum), vc)
        return s_new, o_inter + o_intra

    s_fin, o = lax.scan(step, s0, (to_chunks(q), to_chunks(k), to_chunks(v), to_chunks(log_a)))
    o = o.transpose(1, 2, 0, 3, 4).reshape(b_, h_, l_, dv)
    return o.astype(q.dtype), s_fin


def gla_bidir(q, k, v, la_f, la_b, s0_f, s0_b):
    o_f, s_f = gla_chunk_scan(q, k, v, la_f, s0_f)
    flip = lambda t: jnp.flip(t, axis=2)
    o_b, s_b = gla_chunk_scan(flip(q), flip(k), flip(v), flip(la_b), s0_b)
    return o_f + flip(o_b), s_f, s_b


def gla_inputs(parts, w_dec, b_dec):
    q, k, v, _, a_f, a_b = parts[:6]
    qh = to_heads(q * (GLA_DK ** -0.5), GLA_DK)
    kh = to_heads(k, GLA_DK)
    vh = to_heads(v, GLA_DV)
    la_f = to_heads(jax.nn.log_sigmoid(a_f @ w_dec[0] + b_dec[0]) / GATE_NORMALIZER, GLA_DK)
    la_b = to_heads(jax.nn.log_sigmoid(a_b @ w_dec[1] + b_dec[1]) / GATE_NORMALIZER, GLA_DK)
    return qh, kh, vh, la_f, la_b


def gla_output(o, g, gain):
    b_, h_, l_, dv = o.shape
    on = rmsnorm(o, gain).transpose(0, 2, 1, 3).reshape(b_, l_, h_ * dv)
    return on * jax.nn.silu(g)


def short_conv(gate_b, gate_c, h, w, n_seg, seg_len):
    b_, l_, ch = h.shape
    u = (gate_c * h).reshape(b_ * n_seg, seg_len, ch)
    y = lax.conv_general_dilated(u, w[:, None, :].astype(u.dtype), window_strides=(1,), padding='SAME',
                                 dimension_numbers=('NWC', 'WIO', 'NWC'), feature_group_count=ch)
    return gate_b * y.reshape(b_, l_, ch)


def swiglu(h, w1, w3, w2):
    return (jax.nn.silu(h @ w1) * (h @ w3)) @ w2


def moe_swiglu(h, w_r, w1e, w3e, w2e):
    logits = (h @ w_r).astype(jnp.float32)
    vals, idx = lax.top_k(logits, TOP_K)
    wts = jax.nn.softmax(vals, axis=-1)
    comb = jnp.sum(jax.nn.one_hot(idx, N_EXPERTS, dtype=jnp.float32) * wts[..., None], axis=-2).astype(h.dtype)
    out = jnp.zeros_like(h)
    for e in range(N_EXPERTS):
        out = out + comb[..., e:e + 1] * swiglu(h, w1e[e], w3e[e], w2e[e])
    return out


def setup_inputs(seed: int = 0) -> dict:
    key = jax.random.key(seed)
    ks = iter(jax.random.split(key, 32))
    nrm = lambda shape, scale: jax.random.normal(next(ks), shape, jnp.float32) * scale
    gain = lambda shape: 1.0 + nrm(shape, 0.02)
    d = D_MODEL
    return {
        "x": nrm((BATCH, SEQ, d), 1.0),
        "c": nrm((BATCH, d), 1.0),
        "ctx": nrm((BATCH, CTX_LEN, d), 1.0),
        "c_ctx": nrm((d,), 1.0),
        "w_mod": nrm((DEPTH, d, 6 * d), d ** -0.5),
        "b_mod": nrm((DEPTH, 6 * d), 0.02),
        "g_mix_pre": gain((DEPTH, d)),
        "g_mix_post": gain((DEPTH, d)),
        "w_in": nrm((DEPTH, d, PROJ_W), d ** -0.5),
        "w_decay": nrm((DEPTH, 2, DECAY_RANK, GLA_KW), DECAY_RANK ** -0.5),
        "b_decay": nrm((DEPTH, 2, GLA_KW), 0.5),
        "gla_norm": gain((DEPTH, GLA_DV)),
        "conv_w": nrm((DEPTH, CONV_K, CONV_CH), CONV_K ** -0.5),
        "w_out": nrm((DEPTH, MIX_W, d), MIX_W ** -0.5),
        "g_ffn_pre": gain((DEPTH, d)),
        "g_ffn_post": gain((DEPTH, d)),
        "w1": nrm((N_DENSE, d, D_FF), d ** -0.5),
        "w3": nrm((N_DENSE, d, D_FF), d ** -0.5),
        "w2": nrm((N_DENSE, D_FF, d), D_FF ** -0.5),
        "w_router": nrm((N_MOE, d, N_EXPERTS), d ** -0.5),
        "e_w1": nrm((N_MOE, N_EXPERTS, d, D_FF_EXPERT), d ** -0.5),
        "e_w3": nrm((N_MOE, N_EXPERTS, d, D_FF_EXPERT), d ** -0.5),
        "e_w2": nrm((N_MOE, N_EXPERTS, D_FF_EXPERT, d), D_FF_EXPERT ** -0.5),
    }


def reference(x, c, ctx, c_ctx, w_mod, b_mod, g_mix_pre, g_mix_post, w_in, w_decay, b_decay, gla_norm,
              conv_w, w_out, g_ffn_pre, g_ffn_post, w1, w3, w2, w_router, e_w1, e_w3, e_w2):
    b_, l_, _ = x.shape
    rows = l_ // GRID_W
    ctx_len = ctx.shape[1]
    silu_c = jax.nn.silu(c)
    silu_cc = jax.nn.silu(c_ctx)
    xc = ctx
    for i in range(DEPTH):
        last = i == DEPTH - 1
        sh1, sc1, gt1, sh2, sc2, gt2 = jnp.split((silu_c @ w_mod[i] + b_mod[i])[:, None, :], 6, axis=-1)
        csh1, csc1, cgt1, csh2, csc2, cgt2 = jnp.split(silu_cc @ w_mod[i] + b_mod[i], 6, axis=-1)

        p = split_proj(modulate(rmsnorm(x, g_mix_pre[i]), sh1, sc1) @ w_in[i])
        pc = split_proj(modulate(rmsnorm(xc, g_mix_pre[i]), csh1, csc1) @ w_in[i])

        s_zero = jnp.zeros((ctx.shape[0], GLA_HEADS, GLA_DK, GLA_DV), jnp.float32)
        o_c, s_f, s_b = gla_bidir(*gla_inputs(pc, w_decay[i], b_decay[i]), s_zero, s_zero)
        o_x, _, _ = gla_bidir(*gla_inputs(p, w_decay[i], b_decay[i]), s_f, s_b)

        y_x = jnp.concatenate([
            gla_output(o_x, p[3], gla_norm[i]),
            short_conv(p[6], p[7], p[8], conv_w[i], rows, GRID_W),
        ], axis=-1) @ w_out[i]
        x = x + gt1 * rmsnorm(y_x, g_mix_post[i])
        if not last:
            y_c = jnp.concatenate([
                gla_output(o_c, pc[3], gla_norm[i]),
                short_conv(pc[6], pc[7], pc[8], conv_w[i], 1, ctx_len),
            ], axis=-1) @ w_out[i]
            xc = xc + cgt1 * rmsnorm(y_c, g_mix_post[i])

        j = i // 2
        if i % 2 == 0:
            ffn = lambda h: swiglu(h, w1[j], w3[j], w2[j])
        else:
            ffn = lambda h: moe_swiglu(h, w_router[j], e_w1[j], e_w3[j], e_w2[j])
        x = x + gt2 * rmsnorm(ffn(modulate(rmsnorm(x, g_ffn_pre[i]), sh2, sc2)), g_ffn_post[i])
        if not last:
            xc = xc + cgt2 * rmsnorm(ffn(modulate(rmsnorm(xc, g_ffn_pre[i]), csh2, csc2)), g_ffn_post[i])
    return x
```

```cpp
#include <hip/hip_runtime.h>
#include <cstdio>
#include <cstdint>

#ifndef MK_PER_PHASE
#define MK_PER_PHASE 0
#endif

namespace pg8 {
#define PG8_LAS __attribute__((address_space(3)))
typedef unsigned short bf16_t;
typedef short bf16x8 __attribute__((ext_vector_type(8)));
typedef float f32x4 __attribute__((ext_vector_type(4)));
typedef unsigned u32x4 __attribute__((ext_vector_type(4)));
constexpr int BM = 256, BK = 64, HALF = 128, HTB = HALF * BK * 2, STAGE_BYTES = 8 * HTB, NXCD = 8, WGM = 8;

__host__ __device__ __forceinline__ int lds_byte(int r, int c) { const int st = (r >> 4) * 2 + (c >> 5), rr = r & 15, cc = c & 31, ob = rr * 64 + cc * 2; return st * 1024 + (ob ^ (((ob >> 9) & 1) << 5)); }
__host__ __device__ __forceinline__ void stage_rc(int b, int& R, int& C) { const int st = b / 1024, sb = b % 1024, swz = sb ^ (((sb >> 9) & 1) << 5); R = (st >> 1) * 16 + swz / 64; C = (st & 1) * 32 + (swz % 64) / 2; }
__host__ __device__ __forceinline__ int perm32(int rho) { const int n = rho >> 4, i = rho & 15; return 8 * (i >> 2) + 4 * n + (i & 3); }

struct Unit { int pm, pn; };
struct Gemm { const bf16_t* A; const bf16_t* Bt; int M, N, K; };

struct StaticOrder {
    int nM, nN, nwg, G, c;
    __host__ __device__ void init(int M, int N, int G_, int c_) { nM = M / BM; nN = N / BM; nwg = nM * nN; G = G_; c = c_; }
    __host__ __device__ bool next(int i, Unit& u) const {
        const long L = (long)i * G + c; if (L >= nwg) return false;
        int wgid = (int)L; { const int q = nwg / NXCD, r = nwg % NXCD, xcd = wgid % NXCD, off = wgid / NXCD; wgid = (xcd < r ? xcd * (q + 1) : r * (q + 1) + (xcd - r) * q) + off; }
        const int nig = WGM * nN, gid = wgid / nig, fm = gid * WGM, gsz = (nM - fm) < WGM ? (nM - fm) : WGM;
        u.pm = fm + ((wgid % nig) % gsz); u.pn = (wgid % nig) / gsz; return true;
    }
    __device__ __forceinline__ const char* bptr(const Gemm& g, const Unit& u, size_t tstep) const { return (const char*)g.Bt + (size_t)u.pn * tstep; }
    __device__ __forceinline__ void a_ready(const Unit&) const {}
    __device__ __forceinline__ void done(const Unit&) const {}
};
struct MoeOrder : StaticOrder {
    const int* texp; size_t ebytes;
    __device__ __forceinline__ const char* bptr(const Gemm& g, const Unit& u, size_t tstep) const {
        const int e = __builtin_amdgcn_readfirstlane(texp[u.pm]);
        return (const char*)g.Bt + (size_t)e * ebytes + (size_t)u.pn * tstep; }
};

__device__ __forceinline__ unsigned cvt_pk_bf16(float lo, float hi) { unsigned r; asm volatile("v_cvt_pk_bf16_f32 %0, %1, %2" : "=v"(r) : "v"(lo), "v"(hi)); return r; }

struct EpiPlain {
    static constexpr bool PERM = true, AFTER_DRAIN = false;
    bf16_t* O; int ldc;
    __device__ __forceinline__ void operator()(const f32x4 (&acc)[2][2][4][2], const Unit& u, int wr, int wc, int fr, int fq) const {
        const int row0 = u.pm * BM + wr * 64 + fr, col0 = u.pn * BM + wc * 32 + 8 * fq;
#pragma unroll
        for (int ai = 0; ai < 2; ++ai)
#pragma unroll
            for (int m = 0; m < 4; ++m) { bf16_t* rowp = O + (size_t)(row0 + ai * HALF + m * 16) * ldc + col0;
#pragma unroll
                for (int bj = 0; bj < 2; ++bj) { const f32x4 v0 = acc[ai][bj][m][0], v1 = acc[ai][bj][m][1];
                    u32x4 w; w.x = cvt_pk_bf16(v0[0], v0[1]); w.y = cvt_pk_bf16(v0[2], v0[3]); w.z = cvt_pk_bf16(v1[0], v1[1]); w.w = cvt_pk_bf16(v1[2], v1[3]);
                    *(u32x4*)(rowp + bj * HALF) = w; } }
    }
};
__device__ __forceinline__ float silu_f(float a) { return a * __builtin_amdgcn_rcpf(1.0f + __builtin_amdgcn_exp2f(-1.44269504f * a)); }
template <int ACT> struct EpiPair {
    static constexpr bool PERM = true, AFTER_DRAIN = false;
    bf16_t* O; int ldc;
    __device__ __forceinline__ void operator()(const f32x4 (&acc)[2][2][4][2], const Unit& u, int wr, int wc, int fr, int fq) const {
        const int row0 = u.pm * BM + wr * 64 + fr, col0 = u.pn * HALF + wc * 32 + 8 * fq;
#pragma unroll
        for (int ai = 0; ai < 2; ++ai)
#pragma unroll
            for (int m = 0; m < 4; ++m) { bf16_t* rowp = O + (size_t)(row0 + ai * HALF + m * 16) * ldc + col0;
                f32x4 v0 = acc[ai][0][m][0], v1 = acc[ai][0][m][1]; const f32x4 g0 = acc[ai][1][m][0], g1 = acc[ai][1][m][1];
                if (ACT == 1) {
#pragma unroll
                    for (int j = 0; j < 4; ++j) { v0[j] = silu_f(v0[j]); v1[j] = silu_f(v1[j]); } }
                v0 = v0 * g0; v1 = v1 * g1;
                u32x4 w; w.x = cvt_pk_bf16(v0[0], v0[1]); w.y = cvt_pk_bf16(v0[2], v0[3]); w.z = cvt_pk_bf16(v1[0], v1[1]); w.w = cvt_pk_bf16(v1[2], v1[3]);
                *(u32x4*)rowp = w; }
    }
};
struct EpiInProj {
    static constexpr bool PERM = true, AFTER_DRAIN = false;
    bf16_t* O; int ldc;
    __device__ __forceinline__ void operator()(const f32x4 (&acc)[2][2][4][2], const Unit& u, int wr, int wc, int fr, int fq) const {
        if (u.pn >= 8 && u.pn < 12) { Unit v; v.pm = u.pm; v.pn = u.pn - 8; EpiPair<0> E{O + 2048, ldc}; E(acc, v, wr, wc, fr, fq); }
        else { Unit v; v.pm = u.pm; v.pn = (u.pn == 12) ? 10 : u.pn; EpiPlain E{O, ldc}; E(acc, v, wr, wc, fr, fq); }
    }
};

template <class Epi, class Sched>
__device__ __forceinline__ void gemm_phase(PG8_LAS unsigned char* lds, const Gemm g, const Sched& S, const Epi& E) {
    constexpr bool ALIGN_EPI = true;
    int tid_ = threadIdx.x; asm volatile("" : "+v"(tid_));
    const int tid = tid_, wid = __builtin_amdgcn_readfirstlane(tid >> 6), lane = tid & 63, wr = wid >> 2, wc = wid & 3, fr = lane & 15, fq = lane >> 4;
    const int K = g.K, nt = K / BK;
    unsigned voffA[2], voffB[2];
#pragma unroll
    for (int i = 0; i < 2; ++i) { int R, C; stage_rc(tid * 16 + i * 8192, R, C); const int Rb = Epi::PERM ? ((R & ~31) + perm32(R & 31)) : R;
        voffA[i] = (unsigned)(R * K + C) * 2u; voffB[i] = (unsigned)(Rb * K + C) * 2u; }
    const size_t kstep = (size_t)(BK * 2);
    const size_t hstep = (size_t)HALF * K * 2;
    const size_t tstep = 2 * hstep;
    const unsigned ldsw = (unsigned)wid * 1024u;
    const int aoff = lds_byte(wr * 64 + fr, fq * 8), boff = lds_byte(wc * 32 + fr, fq * 8);
#define PG8_SA(b, h) (((b) * 2 + (h)) * HTB)
#define PG8_SB(b, h) ((4 + (b) * 2 + (h)) * HTB)
#define PG8_STAGE(bufoff, gbase, voff) do { _Pragma("unroll") for (int _i = 0; _i < 2; ++_i) \
        __builtin_amdgcn_global_load_lds((const unsigned*)((const char*)(gbase) + (voff)[_i]), (PG8_LAS unsigned*)(lds + (bufoff) + ldsw + _i * 8192), 16, 0, 0); } while (0)
#define PG8_LDA(dst, b, h) do { _Pragma("unroll") for (int m = 0; m < 4; ++m) _Pragma("unroll") for (int k = 0; k < 2; ++k) dst[m][k] = *(const PG8_LAS bf16x8*)(lds + PG8_SA(b, h) + aoff + m * 2048 + k * 1024); } while (0)
#define PG8_LDB(dst, b, h) do { _Pragma("unroll") for (int n = 0; n < 2; ++n) _Pragma("unroll") for (int k = 0; k < 2; ++k) dst[n][k] = *(const PG8_LAS bf16x8*)(lds + PG8_SB(b, h) + boff + n * 2048 + k * 1024); } while (0)
#define PG8_MMA(ai, bj, At, Bt) do { __builtin_amdgcn_s_setprio(1); _Pragma("unroll") for (int m = 0; m < 4; ++m) _Pragma("unroll") for (int n = 0; n < 2; ++n) _Pragma("unroll") for (int k = 0; k < 2; ++k) \
        acc[ai][bj][m][n] = __builtin_amdgcn_mfma_f32_16x16x32_bf16(Bt[n][k], At[m][k], acc[ai][bj][m][n], 0, 0, 0); __builtin_amdgcn_s_setprio(0); } while (0)
#define PG8_WAIT_V(n) asm volatile("s_waitcnt vmcnt(" #n ")" ::: "memory")
#define PG8_WAIT_L(n) asm volatile("s_waitcnt lgkmcnt(" #n ")" ::: "memory")
#define PG8_BAR __builtin_amdgcn_s_barrier()
#define PG8_SCHED __builtin_amdgcn_sched_barrier(0)
    Unit cur, nxt; int ui = 0;
    if (!S.next(0, cur)) return;
    f32x4 acc[2][2][4][2];
#pragma unroll
    for (int a = 0; a < 2; ++a)
#pragma unroll
        for (int b = 0; b < 2; ++b)
#pragma unroll
            for (int m = 0; m < 4; ++m)
#pragma unroll
                for (int n = 0; n < 2; ++n) acc[a][b][m][n] = (f32x4){0.f, 0.f, 0.f, 0.f};
    bf16x8 At[4][2], B0[2][2], B1[2][2];
    const char* cA = (const char*)g.A + (size_t)cur.pm * tstep; const char* cB = S.bptr(g, cur, tstep);
    S.a_ready(cur);
    PG8_STAGE(PG8_SB(0, 0), cB, voffB); PG8_STAGE(PG8_SB(0, 1), cB + hstep, voffB); PG8_STAGE(PG8_SA(0, 0), cA, voffA); PG8_STAGE(PG8_SA(0, 1), cA + hstep, voffA);
    if (wr == 1) PG8_BAR;
    PG8_WAIT_V(2); PG8_BAR;
    PG8_STAGE(PG8_SB(1, 0), cB + kstep, voffB); PG8_STAGE(PG8_SA(1, 0), cA + kstep, voffA); PG8_STAGE(PG8_SB(1, 1), cB + hstep + kstep, voffB);
    PG8_WAIT_V(6); PG8_BAR;
    for (;;) {
        const bool has_next = S.next(ui + 1, nxt);
        const char* nA = has_next ? (const char*)g.A + (size_t)nxt.pm * tstep : cA; const char* nB = has_next ? S.bptr(g, nxt, tstep) : cB;
        for (int t = 0; t < nt; t += 2) {
            const bool last = (t == nt - 2);
            const char* a1 = cA + (size_t)(t + 1) * kstep;
            const char* a2 = last ? nA : cA + (size_t)(t + 2) * kstep; const char* b2 = last ? nB : cB + (size_t)(t + 2) * kstep;
            const char* a3 = a2 + kstep; const char* b3 = b2 + kstep;
            if (last && has_next) S.a_ready(nxt);
            PG8_LDB(B0, 0, 0); PG8_LDB(B1, 0, 1); PG8_SCHED; PG8_LDA(At, 0, 0); PG8_STAGE(PG8_SA(1, 1), a1 + hstep, voffA);
            PG8_WAIT_V(8); PG8_WAIT_L(0); PG8_BAR; PG8_MMA(0, 0, At, B0); PG8_MMA(0, 1, At, B1); PG8_BAR; PG8_SCHED;
            PG8_LDA(At, 0, 1); PG8_STAGE(PG8_SB(0, 0), b2, voffB); PG8_STAGE(PG8_SB(0, 1), b2 + hstep, voffB); PG8_STAGE(PG8_SA(0, 0), a2, voffA);
            PG8_WAIT_V(8); PG8_WAIT_L(0); PG8_BAR; PG8_MMA(1, 0, At, B0); PG8_MMA(1, 1, At, B1); PG8_BAR; PG8_SCHED;
            PG8_LDB(B0, 1, 0); PG8_LDB(B1, 1, 1); PG8_SCHED; PG8_LDA(At, 1, 0); PG8_STAGE(PG8_SA(0, 1), a2 + hstep, voffA);
            PG8_WAIT_V(8); PG8_WAIT_L(0); PG8_BAR; PG8_MMA(0, 0, At, B0); PG8_MMA(0, 1, At, B1); PG8_BAR; PG8_SCHED;
            PG8_LDA(At, 1, 1); PG8_STAGE(PG8_SB(1, 0), b3, voffB); PG8_STAGE(PG8_SB(1, 1), b3 + hstep, voffB); PG8_STAGE(PG8_SA(1, 0), a3, voffA);
            PG8_WAIT_V(8); PG8_WAIT_L(0); PG8_BAR; PG8_MMA(1, 0, At, B0); PG8_MMA(1, 1, At, B1); PG8_BAR; PG8_SCHED;
        }
        if constexpr (ALIGN_EPI) { if (wr == 0) PG8_BAR; }
        E(acc, cur, wr, wc, fr, fq); S.done(cur);
        if (!has_next) break;
#pragma unroll
        for (int a = 0; a < 2; ++a)
#pragma unroll
            for (int b = 0; b < 2; ++b)
#pragma unroll
                for (int m = 0; m < 4; ++m)
#pragma unroll
                    for (int n = 0; n < 2; ++n) acc[a][b][m][n] = (f32x4){0.f, 0.f, 0.f, 0.f};
        cur = nxt; cA = nA; cB = nB; ++ui;
        if constexpr (ALIGN_EPI) { if (wr == 1) PG8_BAR; }
    }
    PG8_WAIT_V(0);
    if constexpr (!ALIGN_EPI) { if (wr == 0) PG8_BAR; }
    PG8_BAR;
#undef PG8_SA
#undef PG8_SB
#undef PG8_STAGE
#undef PG8_LDA
#undef PG8_LDB
#undef PG8_MMA
#undef PG8_WAIT_V
#undef PG8_WAIT_L
#undef PG8_BAR
#undef PG8_SCHED
}
}

constexpr int NWAVES = 8, NTHR = 512;
constexpr int D = 1024, NB = 16, SEQ = 4096, CTXL = 256;
constexpr int ML = NB * SEQ;
constexpr int MC = NB * CTXL;
constexpr int MT = ML + MC;
constexpr int NPROJ_SRC = 3104;
constexpr int NPROJ = 3328;
constexpr int LDP = 2816;
constexpr int PQ = 0, PK = 256, PV = 512, PGT = 1024, PB = 1536, PU = 2048, PA = 2560;
constexpr int DFF = 2816, NEXP = 8, DFFE = 3584;
constexpr int NCHUNK = MT / 64;
constexpr int MAXSLOT = 2 * ML + NEXP * 256;
constexpr int MAXTILE = MAXSLOT / 256;
constexpr int GROUP_TILES = 128;
constexpr int MAXGROUPS = 5;
constexpr float EPS = 1e-6f;

constexpr size_t MiB = 1u << 20;
constexpr size_t WS_CTL = 0, CTL_ZERO_BYTES = 1 * MiB;
constexpr size_t WS_MOD = 1 * MiB;
constexpr size_t WS_DC = 2 * MiB;
constexpr size_t WS_TOK = 5 * MiB;
constexpr size_t WS_WIN = 8 * MiB;
constexpr size_t WS_WOUT = WS_WIN + (size_t)2 * NPROJ * D * 2;
constexpr size_t WS_W13 = WS_WOUT + (size_t)2 * D * D * 2;
constexpr size_t WS_W2 = WS_W13 + (size_t)2 * DFF * D * 2;
constexpr size_t WS_E13 = WS_W2 + (size_t)D * DFF * 2;
constexpr size_t WS_E2 = WS_E13 + (size_t)NEXP * 2 * DFFE * D * 2;
constexpr size_t WS_XC = WS_E2 + (size_t)NEXP * D * DFFE * 2;
constexpr size_t WS_H = WS_XC + (size_t)MC * D * 4;
constexpr size_t WS_US = WS_H + (size_t)MT * D * 2;
constexpr size_t WS_P = WS_US + (size_t)NCHUNK * 8 * 8192 * 2;
constexpr size_t WS_END = WS_P + (size_t)MT * LDP * 2;
constexpr size_t WS_HID_MOE = WS_H;
static_assert(WS_HID_MOE + (size_t)GROUP_TILES * 256 * DFFE * 2 <= WS_P, "moe hidden overlay");
static_assert((size_t)MAXSLOT * D * 2 <= (size_t)MT * LDP * 2, "gathered rows fit the P region");
static_assert(WS_END <= (size_t)1024 * MiB, "workspace");
constexpr size_t TOK_E = 0;
constexpr size_t TOK_W = 256 * 1024;
constexpr size_t TOK_RANK = 768 * 1024;
constexpr size_t TOK_SLOT = 1280 * 1024;
constexpr size_t TOK_WGBASE = 1792 * 1024;
constexpr size_t TOK_TEXP = 1800 * 1024;
constexpr int CW_BAR = 4096;
constexpr int CW_ECNT = 8192;

#define GAS __attribute__((address_space(1)))
#define CAS __attribute__((address_space(4)))
#define LAS __attribute__((address_space(3)))
typedef unsigned short bf16;
typedef float f32x4 __attribute__((ext_vector_type(4)));
typedef unsigned u32x4 __attribute__((ext_vector_type(4)));
typedef unsigned u32x2 __attribute__((ext_vector_type(2)));
typedef short bf16x8 __attribute__((ext_vector_type(8)));
#define LDS_WAIT() asm volatile("s_waitcnt lgkmcnt(0)" ::: "memory")

__device__ __forceinline__ unsigned f2bf(float f) { unsigned u = __builtin_bit_cast(unsigned, f); return (u + 0x7fffu + ((u >> 16) & 1u)) >> 16; }
__device__ __forceinline__ unsigned pk2(float lo, float hi) { return f2bf(lo) | (f2bf(hi) << 16); }
__device__ __forceinline__ float bflo(unsigned w) { return __builtin_bit_cast(float, w << 16); }
__device__ __forceinline__ float bfhi(unsigned w) { return __builtin_bit_cast(float, w & 0xffff0000u); }
__device__ __forceinline__ float bf2f(unsigned short b) { return __builtin_bit_cast(float, ((unsigned)b) << 16); }
__device__ __forceinline__ float wave_sum(float v) {
#pragma unroll
    for (int o = 1; o < 64; o <<= 1) v += __shfl_xor(v, o);
    return v;
}

#define XB_TMO      128
#define XB_XCNT(j)  (256  + 64 * (j))
#define XB_XSUB(j)  (1280 + 64 * (j))
#define XB_XGEN(j)  (2304 + 64 * (j))
#define XB_TOP      3328
#define XB_TOPGEN   3392
#define XCD_BAR_WORDS 3456
#define XB_SPIN_CAP (1u << 22)
__device__ __forceinline__ unsigned xb_ld(unsigned* p)              { return __hip_atomic_load((GAS unsigned*)p, __ATOMIC_RELAXED, __HIP_MEMORY_SCOPE_AGENT); }
__device__ __forceinline__ unsigned xb_add(unsigned* p, unsigned v) { return __hip_atomic_fetch_add((GAS unsigned*)p, v, __ATOMIC_RELAXED, __HIP_MEMORY_SCOPE_AGENT); }
__device__ __forceinline__ unsigned xb_xcc_id() { return (unsigned)__builtin_amdgcn_s_getreg((3 << 11) | 20) & 0xFu; }
#define XB_SPIN(cond, bar) do { unsigned _sp = 0; while (cond) { __builtin_amdgcn_s_sleep(1); \
    if ((++_sp & 255u) == 0u) { if (xb_ld(&(bar)[XB_TMO])) break; if (_sp > XB_SPIN_CAP) { atomicAdd(&(bar)[XB_TMO], 1u); break; } } } } while (0)
struct XcdBarrier { unsigned* bar; unsigned x; volatile LAS unsigned* st; };
__device__ __forceinline__ XcdBarrier xcd_barrier_post(unsigned* bar, volatile LAS unsigned* st) {
    XcdBarrier b; b.bar = bar; b.x = xb_xcc_id(); b.st = st;
    if (threadIdx.x == 0) (void)xb_add(&bar[XB_XCNT(b.x)], 1u);
    return b;
}
__device__ __forceinline__ void xcd_barrier_complete(unsigned* bar, unsigned x, unsigned& nloc, unsigned& nx) {
    const unsigned G = gridDim.x * gridDim.y * gridDim.z;
    unsigned sum, cnt, mine, sp = 0u;
    for (;;) {
        sum = 0u; cnt = 0u; mine = 0u;
#pragma unroll
        for (unsigned j = 0; j < 16; ++j) { const unsigned c = xb_ld(&bar[XB_XCNT(j)]); sum += c; cnt += (c > 0u) ? 1u : 0u; mine = (j == x) ? c : mine; }
        if (sum == G) break;
        __builtin_amdgcn_s_sleep(1);
        if ((++sp & 255u) == 0u) { if (xb_ld(&bar[XB_TMO])) break; if (sp > XB_SPIN_CAP) { atomicAdd(&bar[XB_TMO], 1u); break; } }
    }
    nloc = mine > 0u ? mine : 1u; nx = cnt > 0u ? cnt : 1u;
}
__device__ __forceinline__ void xcd_barrier(const XcdBarrier& b) {
    asm volatile("s_waitcnt vmcnt(0)" ::: "memory");
    __syncthreads();
    if (threadIdx.x == 0) {
        unsigned* bar = b.bar;
        __builtin_amdgcn_s_waitcnt(0);
        unsigned nloc = b.st[0], nx = b.st[1];
        if (nloc == 0u) { xcd_barrier_complete(bar, b.x, nloc, nx); b.st[0] = nloc; b.st[1] = nx; }
        const unsigned old = xb_add(&bar[XB_XSUB(b.x)], 1u);
        const unsigned gen = old / nloc;
        if (old + 1u == (gen + 1u) * nloc) {
            __builtin_amdgcn_fence(__ATOMIC_RELEASE, "agent");
            asm volatile("s_waitcnt vmcnt(0)" ::: "memory");
            const unsigned og = xb_add(&bar[XB_TOP], 1u);
            const unsigned tg = og / nx;
            if (og + 1u == (tg + 1u) * nx) xb_add(&bar[XB_TOPGEN], 1u);
            else XB_SPIN(xb_ld(&bar[XB_TOPGEN]) == tg, bar);
            __builtin_amdgcn_fence(__ATOMIC_ACQUIRE, "agent");
            xb_add(&bar[XB_XGEN(b.x)], 1u);
            asm volatile("s_waitcnt vmcnt(0)" ::: "memory");
        } else {
            XB_SPIN(xb_ld(&bar[XB_XGEN(b.x)]) == gen, bar);
            __builtin_amdgcn_fence(__ATOMIC_ACQUIRE, "agent");
            asm volatile("s_waitcnt vmcnt(0)" ::: "memory");
        }
    }
    __syncthreads();
}

constexpr int RING_BYTES = 131072;
constexpr int LDSCTL_OFF = RING_BYTES;
constexpr int LDS_BYTES = 147456;

struct Args {
    const float* in[23]; float* out; unsigned char* ws; int ph_lo, ph_hi;
};
struct DArgs {
    const __attribute__((address_space(1))) float* in[23]; __attribute__((address_space(1))) float* out; __attribute__((address_space(1))) unsigned char* ws; int ph_lo, ph_hi;
};
static_assert(sizeof(Args) == sizeof(DArgs), "Args layout");

__device__ __forceinline__ int fresh_tid() { int t = threadIdx.x; asm volatile("" : "+v"(t)); return t; }
#define PHASE_IDS() const int tid = fresh_tid(), lane = tid & 63, wave = __builtin_amdgcn_readfirstlane(tid >> 6); const int G = gridDim.x, wg = blockIdx.x; \
    const int vcu = (G % 8 == 0) ? (wg % 8) * (G / 8) + wg / 8 : wg; const int gw = vcu * NWAVES + wave, NGW = G * NWAVES; (void)tid; (void)lane; (void)wave; (void)vcu; (void)gw; (void)NGW;
#define AIN(k) ((const float*)a.in[k])
#define AOUT ((float*)a.out)
#define AWS ((unsigned char*)a.ws)
struct Row { f32x4 v[4]; };
__device__ __forceinline__ Row ld_row_f32(const float* p, int lane) { Row r;
#pragma unroll
    for (int j = 0; j < 4; ++j) r.v[j] = *(const f32x4*)(p + 256 * j + 4 * lane);
    return r; }
__device__ __forceinline__ Row ld_row_bf16(const bf16* p, int lane) { Row r;
#pragma unroll
    for (int j = 0; j < 4; ++j) { const u32x2 w = *(const u32x2*)(p + 256 * j + 4 * lane); r.v[j] = (f32x4){bflo(w.x), bfhi(w.x), bflo(w.y), bfhi(w.y)}; }
    return r; }
__device__ __forceinline__ void st_row_f32(float* p, int lane, const Row& r) {
#pragma unroll
    for (int j = 0; j < 4; ++j) *(f32x4*)(p + 256 * j + 4 * lane) = r.v[j]; }
__device__ __forceinline__ void st_row_bf16(bf16* p, int lane, const Row& r) {
#pragma unroll
    for (int j = 0; j < 4; ++j) { u32x2 w; w.x = pk2(r.v[j][0], r.v[j][1]); w.y = pk2(r.v[j][2], r.v[j][3]); *(u32x2*)(p + 256 * j + 4 * lane) = w; } }
__device__ __forceinline__ float row_rstd(const Row& r) { float s = 0.f;
#pragma unroll
    for (int j = 0; j < 4; ++j) s += (r.v[j][0] * r.v[j][0] + r.v[j][1] * r.v[j][1]) + (r.v[j][2] * r.v[j][2] + r.v[j][3] * r.v[j][3]);
    return 1.0f / sqrtf(wave_sum(s) * (1.0f / D) + EPS); }
__device__ __forceinline__ const float* modp(const float* MOD, int l, int bb, int which) { return MOD + ((size_t)(l * 17 + bb) * 6 + which) * D; }
__device__ __forceinline__ int row_bb(int r) { return r < ML ? (r >> 12) : 16; }

__device__ __forceinline__ void transpose_item(const float* W, int K, int N, bf16* WT, int drow0, int k0, int n0, LAS float* scr, int lane) {
#pragma unroll 8
    for (int i = 0; i < 32; ++i) { const int kk = 2 * i + (lane >> 5); scr[kk * 33 + (lane & 31)] = W[(size_t)(k0 + kk) * N + n0 + (lane & 31)]; }
    LDS_WAIT(); asm volatile("" ::: "memory");
    const int c = lane & 7;
#pragma unroll
    for (int j = 0; j < 4; ++j) { const int n = (lane >> 3) + 8 * j; const LAS float* s = scr + (8 * c) * 33 + n;
        u32x4 o; o.x = pk2(s[0 * 33], s[1 * 33]); o.y = pk2(s[2 * 33], s[3 * 33]); o.z = pk2(s[4 * 33], s[5 * 33]); o.w = pk2(s[6 * 33], s[7 * 33]);
        *(u32x4*)(WT + (size_t)(drow0 + n) * K + k0 + 8 * c) = o; }
    LDS_WAIT(); asm volatile("" ::: "memory");
}
__device__ __forceinline__ int win_drow(int n0) {
    if (n0 < 1536) return n0;
    if (n0 < 1568) return 3072 + (n0 - 1536);
    if (n0 < 2080) return 1536 + (n0 - 1568);
    if (n0 < 2592) { const int j = n0 - 2080; return 2048 + (j >> 7) * 256 + (j & 127); }
    { const int j = n0 - 2592; return 2048 + (j >> 7) * 256 + 128 + (j & 127); }
}
__device__ __forceinline__ int pair_drow(int n0, int second) { return (n0 >> 7) * 256 + second * 128 + (n0 & 127); }

__device__ __forceinline__ void p0_prologue(const CAS DArgs& a, LAS unsigned char* lds) {
    PHASE_IDS();
    unsigned char* ws = AWS;
    {
        LAS float* sc = (LAS float*)lds;
        LAS float* part = (LAS float*)(lds + 17 * 1024 * 4);
        const float* c = AIN(1); const float* cc = AIN(3);
        bool filled = false;
        for (int t = vcu; t < 192; t += G) {
            if (!filled) {
                for (int i = tid; i < 17 * 1024; i += NTHR) { const float v = (i < 16 * 1024) ? c[i] : cc[i - 16 * 1024]; sc[i] = v / (1.0f + __expf(-v)); }
                __syncthreads(); filled = true;
            }
            const int l = t / 96, cb = t % 96, col = cb * 64 + lane;
            const float* wm = AIN(4) + (size_t)l * D * 6144 + col;
            float acc[17];
#pragma unroll
            for (int b = 0; b < 17; ++b) acc[b] = 0.f;
            for (int k = wave * 128; k < wave * 128 + 128; k += 4) {
                float w[4];
#pragma unroll
                for (int q = 0; q < 4; ++q) w[q] = wm[(size_t)(k + q) * 6144];
#pragma unroll
                for (int q = 0; q < 4; ++q)
#pragma unroll
                    for (int b = 0; b < 17; ++b) acc[b] += sc[b * 1024 + k + q] * w[q];
            }
#pragma unroll
            for (int b = 0; b < 17; ++b) part[(wave * 17 + b) * 64 + lane] = acc[b];
            __syncthreads();
            for (int i = tid; i < 17 * 64; i += NTHR) { const int b = i / 64, cl = i % 64; float s = AIN(5)[(size_t)l * 6144 + cb * 64 + cl];
#pragma unroll
                for (int w = 0; w < 8; ++w) s += part[(w * 17 + b) * 64 + cl];
                const int j = cb * 64 + cl;
                ((float*)(ws + WS_MOD))[((size_t)(l * 17 + b) * 6 + (j >> 10)) * D + (j & 1023)] = s; }
            __syncthreads();
        }
        __syncthreads();
    }
    LAS float* scr = (LAS float*)(lds + wave * 16384);
    constexpr int I_IN = 16 * 97, I_OUT = 16 * 32, I_W1 = 16 * 88, I_W2 = 44 * 32, I_E1 = 16 * 112, I_E2 = 56 * 32;
    constexpr int T0 = 2 * I_IN, T1 = T0 + 2 * I_OUT, T2 = T1 + 2 * I_W1, T3 = T2 + I_W2, T4 = T3 + 16 * I_E1, T5 = T4 + 8 * I_E2;
    for (int it = gw; it < T5; it += NGW) {
        if (it < T0) { const int l = it / I_IN, r = it % I_IN, kb = r / 97, nb = r % 97;
            transpose_item(AIN(8) + (size_t)l * D * NPROJ_SRC, D, NPROJ_SRC, (bf16*)(ws + WS_WIN) + (size_t)l * NPROJ * D, win_drow(nb * 32), kb * 64, nb * 32, scr, lane); }
        else if (it < T1) { const int q = it - T0, l = q / I_OUT, r = q % I_OUT, kb = r / 32, nb = r % 32;
            transpose_item(AIN(13) + (size_t)l * D * D, D, D, (bf16*)(ws + WS_WOUT) + (size_t)l * D * D, nb * 32, kb * 64, nb * 32, scr, lane); }
        else if (it < T2) { const int q = it - T1, s = q / I_W1, r = q % I_W1, kb = r / 88, nb = r % 88;
            transpose_item(s ? AIN(17) : AIN(16), D, DFF, (bf16*)(ws + WS_W13), pair_drow(nb * 32, s), kb * 64, nb * 32, scr, lane); }
        else if (it < T3) { const int r = it - T2, kb = r / 32, nb = r % 32;
            transpose_item(AIN(18), DFF, D, (bf16*)(ws + WS_W2), nb * 32, kb * 64, nb * 32, scr, lane); }
        else if (it < T4) { const int q = it - T3, es = q / I_E1, e = es >> 1, s = es & 1, r = q % I_E1, kb = r / 112, nb = r % 112;
            transpose_item((s ? AIN(21) : AIN(20)) + (size_t)e * D * DFFE, D, DFFE, (bf16*)(ws + WS_E13) + (size_t)e * 2 * DFFE * D, pair_drow(nb * 32, s), kb * 64, nb * 32, scr, lane); }
        else { const int q = it - T4, e = q / I_E2, r = q % I_E2, kb = r / 32, nb = r % 32;
            transpose_item(AIN(22) + (size_t)e * DFFE * D, DFFE, D, (bf16*)(ws + WS_E2) + (size_t)e * D * DFFE, nb * 32, kb * 64, nb * 32, scr, lane); }
    }
    for (int i = gw * 64 + lane; i < 2 * 224 * 128; i += NGW * 64) { const int l = i / (224 * 128), r = i % (224 * 128);
        *(u32x4*)((bf16*)(ws + WS_WIN) + (size_t)l * NPROJ * D + (size_t)3104 * D + (size_t)r * 8) = (u32x4){0u, 0u, 0u, 0u}; }
}

__device__ __forceinline__ void phase_normmod0(const CAS DArgs& a) {
    PHASE_IDS();
    const float* MOD = (const float*)(AWS + WS_MOD); bf16* H = (bf16*)(AWS + WS_H);
    for (int r = gw; r < MT; r += NGW) {
        const float* src = r < ML ? AIN(0) + (size_t)r * D : AIN(2) + (size_t)(r - ML) * D;
        const int bb = row_bb(r);
        Row x = ld_row_f32(src, lane); const float rs = row_rstd(x);
        const Row g = ld_row_f32(AIN(6), lane), sc = ld_row_f32(modp(MOD, 0, bb, 1), lane), sh = ld_row_f32(modp(MOD, 0, bb, 0), lane);
#pragma unroll
        for (int j = 0; j < 4; ++j) x.v[j] = x.v[j] * rs * g.v[j] * (1.0f + sc.v[j]) + sh.v[j];
        st_row_bf16(H + (size_t)r * D, lane, x);
    }
}
__device__ __forceinline__ void phase_postmix(const CAS DArgs& a, int l, LAS unsigned char* lds) {
    const int tid = fresh_tid(), lane = tid & 63, wave = __builtin_amdgcn_readfirstlane(tid >> 6); const int G = gridDim.x, wg = blockIdx.x;
    const float* MOD = (const float*)(AWS + WS_MOD); bf16* H = (bf16*)(AWS + WS_H); const bf16* Y = (const bf16*)(AWS + WS_P);
    float* XC = (float*)(AWS + WS_XC);
    const int nrows = l == 0 ? MT : ML;
    const int gw = wg * NWAVES + wave, NGW = G * NWAVES;
    LAS float* wr_l = (LAS float*)lds;
    LAS unsigned* lcnt = (LAS unsigned*)(lds + LDSCTL_OFF + 64);
    if (l == 1) {
        for (int i = tid; i < D * NEXP; i += NTHR) wr_l[i] = AIN(19)[i];
        if (tid < 8) lcnt[tid] = 0u;
        __syncthreads();
    }
    for (int r = gw; r < nrows; r += NGW) {
        const int bb = row_bb(r);
        const float* xsrc = l == 0 ? (r < ML ? AIN(0) + (size_t)r * D : AIN(2) + (size_t)(r - ML) * D) : AOUT + (size_t)r * D;
        float* xdst = r < ML ? AOUT + (size_t)r * D : XC + (size_t)(r - ML) * D;
        Row y = ld_row_bf16(Y + (size_t)r * D, lane); Row x = ld_row_f32(xsrc, lane);
        const float rs = row_rstd(y);
        { const Row g = ld_row_f32(AIN(7) + (size_t)l * D, lane), gt = ld_row_f32(modp(MOD, l, bb, 2), lane);
#pragma unroll
          for (int j = 0; j < 4; ++j) x.v[j] = x.v[j] + gt.v[j] * (y.v[j] * rs * g.v[j]); }
        st_row_f32(xdst, lane, x);
        const float rs2 = row_rstd(x);
        { const Row g = ld_row_f32(AIN(14) + (size_t)l * D, lane), sc = ld_row_f32(modp(MOD, l, bb, 4), lane), sh = ld_row_f32(modp(MOD, l, bb, 3), lane);
#pragma unroll
          for (int j = 0; j < 4; ++j) x.v[j] = x.v[j] * rs2 * g.v[j] * (1.0f + sc.v[j]) + sh.v[j]; }
        st_row_bf16(H + (size_t)r * D, lane, x);
        if (l == 1) {
            float lg[8];
#pragma unroll
            for (int e = 0; e < 8; ++e) lg[e] = 0.f;
#pragma unroll
            for (int j = 0; j < 4; ++j)
#pragma unroll
                for (int q = 0; q < 4; ++q) { const LAS f32x4* wp = (const LAS f32x4*)(wr_l + (256 * j + 4 * lane + q) * 8); const f32x4 w0 = wp[0], w1 = wp[1]; const float xv = x.v[j][q];
                    lg[0] += xv * w0[0]; lg[1] += xv * w0[1]; lg[2] += xv * w0[2]; lg[3] += xv * w0[3]; lg[4] += xv * w1[0]; lg[5] += xv * w1[1]; lg[6] += xv * w1[2]; lg[7] += xv * w1[3]; }
#pragma unroll
            for (int e = 0; e < 8; ++e) lg[e] = wave_sum(lg[e]);
            int e0 = 0; float v0 = lg[0];
#pragma unroll
            for (int e = 1; e < 8; ++e) if (lg[e] > v0) { v0 = lg[e]; e0 = e; }
            int e1 = -1; float v1 = -3.0e38f;
#pragma unroll
            for (int e = 0; e < 8; ++e) if (e != e0 && lg[e] > v1) { v1 = lg[e]; e1 = e; }
            if (lane == 0) {
                const float w1 = 1.0f / (1.0f + __expf(v0 - v1)), w0 = 1.0f - w1;
                const unsigned r0 = __hip_atomic_fetch_add(lcnt + e0, 1u, __ATOMIC_RELAXED, __HIP_MEMORY_SCOPE_WORKGROUP), r1 = __hip_atomic_fetch_add(lcnt + e1, 1u, __ATOMIC_RELAXED, __HIP_MEMORY_SCOPE_WORKGROUP);
                unsigned char* tk = AWS + WS_TOK;
                ((unsigned*)(tk + TOK_E))[r] = (unsigned)e0 | ((unsigned)e1 << 8);
                ((float*)(tk + TOK_W))[2 * r] = w0; ((float*)(tk + TOK_W))[2 * r + 1] = w1;
                ((unsigned*)(tk + TOK_RANK))[2 * r] = r0; ((unsigned*)(tk + TOK_RANK))[2 * r + 1] = r1;
            }
        }
    }
    if (l == 1) {
        __syncthreads();
        if (tid < 8) { const unsigned n = lcnt[tid];
            const unsigned base = __hip_atomic_fetch_add((unsigned*)(AWS + WS_CTL) + CW_ECNT + tid, n, __ATOMIC_RELAXED, __HIP_MEMORY_SCOPE_AGENT);
            ((unsigned*)(AWS + WS_TOK + TOK_WGBASE))[wg * 8 + tid] = base; }
        __syncthreads();
    }
}
__device__ __forceinline__ void phase_postffn0(const CAS DArgs& a) {
    PHASE_IDS();
    const float* MOD = (const float*)(AWS + WS_MOD); bf16* H = (bf16*)(AWS + WS_H); float* XC = (float*)(AWS + WS_XC);
    for (int r = gw; r < MT; r += NGW) {
        const int bb = row_bb(r);
        float* xp = r < ML ? AOUT + (size_t)r * D : XC + (size_t)(r - ML) * D;
        Row y = ld_row_bf16(H + (size_t)r * D, lane); Row x = ld_row_f32(xp, lane);
        const float rs = row_rstd(y);
        { const Row g = ld_row_f32(AIN(15), lane), gt = ld_row_f32(modp(MOD, 0, bb, 5), lane);
#pragma unroll
          for (int j = 0; j < 4; ++j) x.v[j] = x.v[j] + gt.v[j] * (y.v[j] * rs * g.v[j]); }
        st_row_f32(xp, lane, x);
        const float rs2 = row_rstd(x);
        { const Row g = ld_row_f32(AIN(6) + D, lane), sc = ld_row_f32(modp(MOD, 1, bb, 1), lane), sh = ld_row_f32(modp(MOD, 1, bb, 0), lane);
#pragma unroll
          for (int j = 0; j < 4; ++j) x.v[j] = x.v[j] * rs2 * g.v[j] * (1.0f + sc.v[j]) + sh.v[j]; }
        st_row_bf16(H + (size_t)r * D, lane, x);
    }
}
__device__ __forceinline__ void phase_final(const CAS DArgs& a) {
    PHASE_IDS();
    const float* MOD = (const float*)(AWS + WS_MOD); const bf16* YS = (const bf16*)(AWS + WS_P);
    const unsigned char* tk = AWS + WS_TOK;
    for (int r = gw; r < ML; r += NGW) {
        const int bb = r >> 12;
        const unsigned s0 = ((const unsigned*)(tk + TOK_SLOT))[2 * r], s1 = ((const unsigned*)(tk + TOK_SLOT))[2 * r + 1];
        const float w0 = ((const float*)(tk + TOK_W))[2 * r], w1 = ((const float*)(tk + TOK_W))[2 * r + 1];
        Row y = ld_row_bf16(YS + (size_t)s0 * D, lane); const Row y1 = ld_row_bf16(YS + (size_t)s1 * D, lane);
#pragma unroll
        for (int j = 0; j < 4; ++j) y.v[j] = y.v[j] * w0 + y1.v[j] * w1;
        Row x = ld_row_f32(AOUT + (size_t)r * D, lane);
        const float rs = row_rstd(y);
        const Row g = ld_row_f32(AIN(15) + D, lane), gt = ld_row_f32(modp(MOD, 1, bb, 5), lane);
#pragma unroll
        for (int j = 0; j < 4; ++j) x.v[j] = x.v[j] + gt.v[j] * (y.v[j] * rs * g.v[j]);
        st_row_f32(AOUT + (size_t)r * D, lane, x);
    }
}
__device__ __forceinline__ void expert_offsets(const unsigned* ecnt, unsigned (&off)[9]) {
    off[0] = 0u;
#pragma unroll
    for (int e = 0; e < 8; ++e) off[e + 1] = off[e] + ((ecnt[e] + 255u) & ~255u);
}
__device__ __forceinline__ void phase_gather(const CAS DArgs& a) {
    const int tid = fresh_tid(), lane = tid & 63, wave = __builtin_amdgcn_readfirstlane(tid >> 6); const int G = gridDim.x, wg = blockIdx.x;
    const int gw = wg * NWAVES + wave, NGW = G * NWAVES;
    unsigned char* tk = AWS + WS_TOK; const unsigned* ecnt = (const unsigned*)(AWS + WS_CTL) + CW_ECNT;
    unsigned cnt[8], off[9];
#pragma unroll
    for (int e = 0; e < 8; ++e) cnt[e] = __hip_atomic_load(ecnt + e, __ATOMIC_RELAXED, __HIP_MEMORY_SCOPE_AGENT);
    expert_offsets(cnt, off);
    const bf16* H = (const bf16*)(AWS + WS_H); bf16* GA = (bf16*)(AWS + WS_P);
    for (int r = gw; r < ML; r += NGW) {
        const int owner = (r % NGW) / NWAVES;
        const unsigned ee = ((const unsigned*)(tk + TOK_E))[r]; const int e0 = ee & 255, e1 = (ee >> 8) & 255;
        const unsigned* wb = (const unsigned*)(tk + TOK_WGBASE) + owner * 8;
        unsigned o0 = 0, o1 = 0;
#pragma unroll
        for (int e = 0; e < 8; ++e) { o0 = (e == e0) ? off[e] : o0; o1 = (e == e1) ? off[e] : o1; }
        const unsigned s0 = o0 + wb[e0] + ((const unsigned*)(tk + TOK_RANK))[2 * r], s1 = o1 + wb[e1] + ((const unsigned*)(tk + TOK_RANK))[2 * r + 1];
        if (lane == 0) { ((unsigned*)(tk + TOK_SLOT))[2 * r] = s0; ((unsigned*)(tk + TOK_SLOT))[2 * r + 1] = s1; }
        const u32x4* src = (const u32x4*)(H + (size_t)r * D);
        const u32x4 v0 = src[lane], v1 = src[64 + lane];
        u32x4* d0 = (u32x4*)(GA + (size_t)s0 * D); u32x4* d1 = (u32x4*)(GA + (size_t)s1 * D);
        d0[lane] = v0; d0[64 + lane] = v1; d1[lane] = v0; d1[64 + lane] = v1;
    }
    for (int e = 0; e < 8; ++e) { const unsigned p0 = off[e] + cnt[e], p1 = off[e + 1];
        for (unsigned s = p0 + gw; s < p1; s += NGW) { u32x4* d = (u32x4*)(GA + (size_t)s * D); d[lane] = (u32x4){0u, 0u, 0u, 0u}; d[64 + lane] = (u32x4){0u, 0u, 0u, 0u}; } }
    if (wg == 0) { int* texp = (int*)(tk + TOK_TEXP);
        for (int t = tid; t < MAXTILE; t += NTHR) { int e = 0;
#pragma unroll
            for (int q = 1; q < 8; ++q) e = ((unsigned)(t * 256) >= off[q]) ? q : e;
            texp[t] = e; } }
}

constexpr int G1P = 72;
constexpr int G1_QT = 0, G1_KT = 18432, G1_KH = 36864, G1_VT = 55296, G1_AT = 73728, G1_WD = 82944, G1_BD = 91136;
__device__ __forceinline__ size_t us_slot(int chunk, int h, int dir) { return ((size_t)(chunk * 4 + h) * 2 + dir) * 8192; }
__device__ __forceinline__ float log_sigmoid(float z) { return fminf(z, 0.f) - __logf(1.0f + __expf(-fabsf(z))); }

__device__ __forceinline__ void phase_gla_local(const CAS DArgs& a, int l, LAS unsigned char* lds) {
    const int tid = fresh_tid(), lane = tid & 63, wave = __builtin_amdgcn_readfirstlane(tid >> 6); const int G = gridDim.x, wg = blockIdx.x;
    bf16* P = (bf16*)(AWS + WS_P); bf16* US = (bf16*)(AWS + WS_US); float* DC = (float*)(AWS + WS_DC);
    LAS bf16* QT = (LAS bf16*)(lds + G1_QT); LAS bf16* KT = (LAS bf16*)(lds + G1_KT); LAS bf16* KH = (LAS bf16*)(lds + G1_KH);
    LAS bf16* VT = (LAS bf16*)(lds + G1_VT); LAS bf16* AT = (LAS bf16*)(lds + G1_AT);
    LAS float* WD = (LAS float*)(lds + G1_WD); LAS float* BD = (LAS float*)(lds + G1_BD);
    const int fr = lane & 15, fq = lane >> 4;
    const int dir = wave >> 2, d0 = (wave & 3) * 16;
    for (int u = wg; u < NCHUNK * 4; u += G) {
        const int chunk = u >> 2, h = u & 3;
        { const int dr = tid >> 8, d = (tid >> 2) & 63, r0 = (tid & 3) * 4;
          const float* wsrc = AIN(9) + ((size_t)(l * 2 + dr) * 16 + r0) * 256 + 64 * h + d;
          *(LAS f32x4*)(WD + (dr * 64 + d) * 16 + r0) = (f32x4){wsrc[0], wsrc[256], wsrc[512], wsrc[768]};
          if (tid < 128) BD[tid] = AIN(10)[(size_t)(l * 2 + (tid >> 6)) * 256 + 64 * h + (tid & 63)];
          __syncthreads(); }
        {
            bf16* prow = P + (size_t)(chunk * 64 + lane) * LDP;
            const u32x4 a0 = *(const u32x4*)(prow + PA + 16 * dir), a1 = *(const u32x4*)(prow + PA + 16 * dir + 8);
            const u32x4 q0 = *(const u32x4*)(prow + PQ + 64 * h + d0), q1 = *(const u32x4*)(prow + PQ + 64 * h + d0 + 8);
            const u32x4 k0 = *(const u32x4*)(prow + PK + 64 * h + d0), k1 = *(const u32x4*)(prow + PK + 64 * h + d0 + 8);
            float av[16], qv[16], kv[16];
#pragma unroll
            for (int i = 0; i < 4; ++i) { av[2 * i] = bflo(a0[i]); av[2 * i + 1] = bfhi(a0[i]); av[8 + 2 * i] = bflo(a1[i]); av[9 + 2 * i] = bfhi(a1[i]);
                qv[2 * i] = bflo(q0[i]); qv[2 * i + 1] = bfhi(q0[i]); qv[8 + 2 * i] = bflo(q1[i]); qv[9 + 2 * i] = bfhi(q1[i]);
                kv[2 * i] = bflo(k0[i]); kv[2 * i + 1] = bfhi(k0[i]); kv[8 + 2 * i] = bflo(k1[i]); kv[9 + 2 * i] = bfhi(k1[i]); }
            unsigned qpk[8];
            float dtot = 0.f;
#pragma unroll
            for (int dd = 0; dd < 16; ++dd) {
                const LAS f32x4* wv = (const LAS f32x4*)(WD + (dir * 64 + d0 + dd) * 16);
                const f32x4 w0 = wv[0], w1 = wv[1], w2 = wv[2], w3 = wv[3];
                float z = BD[dir * 64 + d0 + dd];
#pragma unroll
                for (int r = 0; r < 4; ++r) z += av[r] * w0[r] + av[4 + r] * w1[r] + av[8 + r] * w2[r] + av[12 + r] * w3[r];
                const float la = log_sigmoid(z) * (1.0f / 16.0f);
                float inc = la;
#pragma unroll
                for (int o = 1; o < 64; o <<= 1) { const float t = __shfl_up(inc, o); inc += (lane >= o) ? t : 0.f; }
                const float tot = __shfl(inc, 63);
                const float bc = dir == 0 ? inc : (tot - inc + la);
                const float qt = qv[dd] * 0.125f * __expf(bc), kt = kv[dd] * __expf(-bc), kh = kv[dd] * __expf(tot - bc);
                const unsigned qb = f2bf(qt);
                QT[(dir * 64 + lane) * G1P + d0 + dd] = (bf16)qb;
                KT[(dir * 64 + lane) * G1P + d0 + dd] = (bf16)f2bf(kt);
                KH[(dir * 64 + d0 + dd) * G1P + lane] = (bf16)f2bf(kh);
                if (dd & 1) qpk[dd >> 1] |= qb << 16; else qpk[dd >> 1] = qb;
                dtot = (lane == dd) ? __expf(tot) : dtot;
            }
            if (lane < 16) DC[((size_t)(chunk * 4 + h) * 2 + dir) * 64 + d0 + lane] = dtot;
            { const int j = tid >> 3, eb = (tid & 7) * 16; const bf16* vr = P + (size_t)(chunk * 64 + j) * LDP + PV + 128 * h + eb;
              const u32x4 v0 = *(const u32x4*)vr, v1 = *(const u32x4*)(vr + 8);
#pragma unroll
              for (int i = 0; i < 4; ++i) { VT[(eb + 2 * i) * G1P + j] = (bf16)(v0[i] & 0xffffu); VT[(eb + 2 * i + 1) * G1P + j] = (bf16)(v0[i] >> 16);
                  VT[(eb + 8 + 2 * i) * G1P + j] = (bf16)(v1[i] & 0xffffu); VT[(eb + 9 + 2 * i) * G1P + j] = (bf16)(v1[i] >> 16); } }
            __syncthreads();
            bf16* qd = prow + (dir == 0 ? PQ : PK) + 64 * h + d0;
            *(u32x4*)qd = (u32x4){qpk[0], qpk[1], qpk[2], qpk[3]}; *(u32x4*)(qd + 8) = (u32x4){qpk[4], qpk[5], qpk[6], qpk[7]};
        }
#pragma unroll
        for (int t = 0; t < 2; ++t) {
            const int job = wave * 2 + t, jt = job >> 2, it = job & 3;
            f32x4 accf = (f32x4){0.f, 0.f, 0.f, 0.f}, accb = (f32x4){0.f, 0.f, 0.f, 0.f};
#pragma unroll
            for (int ks = 0; ks < 2; ++ks) {
                const bf16x8 ka = *(const LAS bf16x8*)(KT + (0 * 64 + 16 * jt + fr) * G1P + 32 * ks + 8 * fq), qa = *(const LAS bf16x8*)(QT + (0 * 64 + 16 * it + fr) * G1P + 32 * ks + 8 * fq);
                accf = __builtin_amdgcn_mfma_f32_16x16x32_bf16(ka, qa, accf, 0, 0, 0);
                const bf16x8 kb = *(const LAS bf16x8*)(KT + (1 * 64 + 16 * jt + fr) * G1P + 32 * ks + 8 * fq), qb = *(const LAS bf16x8*)(QT + (1 * 64 + 16 * it + fr) * G1P + 32 * ks + 8 * fq);
                accb = __builtin_amdgcn_mfma_f32_16x16x32_bf16(kb, qb, accb, 0, 0, 0);
            }
            const int i = 16 * it + fr, j0 = 16 * jt + 4 * fq;
            float s[4];
#pragma unroll
            for (int r = 0; r < 4; ++r) { const int j = j0 + r; s[r] = (j <= i ? accf[r] : 0.f) + (j >= i ? accb[r] : 0.f); }
            u32x2 w; w.x = pk2(s[0], s[1]); w.y = pk2(s[2], s[3]);
            *(LAS u32x2*)(AT + i * G1P + j0) = w;
        }
        __syncthreads();
        {
            const int et = wave;
            bf16x8 vf[2];
#pragma unroll
            for (int ks = 0; ks < 2; ++ks) vf[ks] = *(const LAS bf16x8*)(VT + (16 * et + fr) * G1P + 32 * ks + 8 * fq);
#pragma unroll
            for (int it = 0; it < 4; ++it) {
                f32x4 acc = (f32x4){0.f, 0.f, 0.f, 0.f};
#pragma unroll
                for (int ks = 0; ks < 2; ++ks) { const bf16x8 af = *(const LAS bf16x8*)(AT + (16 * it + fr) * G1P + 32 * ks + 8 * fq);
                    acc = __builtin_amdgcn_mfma_f32_16x16x32_bf16(vf[ks], af, acc, 0, 0, 0); }
                u32x2 w; w.x = pk2(acc[0], acc[1]); w.y = pk2(acc[2], acc[3]);
                *(u32x2*)(P + (size_t)(chunk * 64 + 16 * it + fr) * LDP + PV + 128 * h + 16 * et + 4 * fq) = w;
            }
#pragma unroll
            for (int dr = 0; dr < 2; ++dr)
#pragma unroll
                for (int dt = 0; dt < 4; ++dt) {
                    f32x4 acc = (f32x4){0.f, 0.f, 0.f, 0.f};
#pragma unroll
                    for (int ks = 0; ks < 2; ++ks) { const bf16x8 kf = *(const LAS bf16x8*)(KH + (dr * 64 + 16 * dt + fr) * G1P + 32 * ks + 8 * fq);
                        acc = __builtin_amdgcn_mfma_f32_16x16x32_bf16(kf, vf[ks], acc, 0, 0, 0); }
                    u32x2 w; w.x = pk2(acc[0], acc[1]); w.y = pk2(acc[2], acc[3]);
                    *(u32x2*)(US + us_slot(chunk, h, dr) + (size_t)(16 * et + fr) * 64 + 16 * dt + 4 * fq) = w;
                }
        }
        __syncthreads();
    }
}
__device__ __forceinline__ void phase_conv(const CAS DArgs& a, int l) {
    const int tid = fresh_tid(); const int G = gridDim.x, wg = blockIdx.x;
    const bf16* P = (const bf16*)(AWS + WS_P); bf16* MIX = (bf16*)(AWS + WS_H);
    const float* cw = AIN(12) + (size_t)l * 3 * 512;
    const int nrows = l == 0 ? MT : ML;
    const long total = (long)nrows * 64;
    for (long it = (long)wg * NTHR + tid; it < total; it += (long)G * NTHR) {
        const int r = (int)(it >> 6), c8 = (int)(it & 63) * 8;
        const int t = r < ML ? (r & 63) : ((r - ML) & 255); const int last = r < ML ? 63 : 255;
        const bf16* pr = P + (size_t)r * LDP;
        const u32x4 uc = *(const u32x4*)(pr + PU + c8), bg = *(const u32x4*)(pr + PB + c8);
        u32x4 up = (u32x4){0u, 0u, 0u, 0u}, un = (u32x4){0u, 0u, 0u, 0u};
        if (t > 0) up = *(const u32x4*)(pr - LDP + PU + c8);
        if (t < last) un = *(const u32x4*)(pr + LDP + PU + c8);
        const f32x4 w0a = *(const f32x4*)(cw + c8), w0b = *(const f32x4*)(cw + c8 + 4), w1a = *(const f32x4*)(cw + 512 + c8), w1b = *(const f32x4*)(cw + 512 + c8 + 4), w2a = *(const f32x4*)(cw + 1024 + c8), w2b = *(const f32x4*)(cw + 1024 + c8 + 4);
        float o[8];
#pragma unroll
        for (int i = 0; i < 4; ++i) {
            const float wl0 = i < 2 ? w0a[2 * i] : w0b[2 * i - 4], wh0 = i < 2 ? w0a[2 * i + 1] : w0b[2 * i - 3];
            const float wl1 = i < 2 ? w1a[2 * i] : w1b[2 * i - 4], wh1 = i < 2 ? w1a[2 * i + 1] : w1b[2 * i - 3];
            const float wl2 = i < 2 ? w2a[2 * i] : w2b[2 * i - 4], wh2 = i < 2 ? w2a[2 * i + 1] : w2b[2 * i - 3];
            o[2 * i] = bflo(bg[i]) * (wl0 * bflo(up[i]) + wl1 * bflo(uc[i]) + wl2 * bflo(un[i]));
            o[2 * i + 1] = bfhi(bg[i]) * (wh0 * bfhi(up[i]) + wh1 * bfhi(uc[i]) + wh2 * bfhi(un[i]));
        }
        *(u32x4*)(MIX + (size_t)r * D + 512 + c8) = (u32x4){pk2(o[0], o[1]), pk2(o[2], o[3]), pk2(o[4], o[5]), pk2(o[6], o[7])};
    }
}
__device__ __forceinline__ void phase_gla_scan(const CAS DArgs& a) {
    const int tid = fresh_tid(); const int G = gridDim.x, wg = blockIdx.x;
    bf16* US = (bf16*)(AWS + WS_US); const float* DC = (const float*)(AWS + WS_DC);
    for (int id = wg * NTHR + tid; id < NB * 4 * 2 * 1024; id += G * NTHR) {
        const int g8 = id & 1023, prob = id >> 10, dir = prob & 1, h = (prob >> 1) & 3, b = prob >> 3;
        const int dg = (g8 & 7) * 8;
        float S[8];
#pragma unroll
        for (int i = 0; i < 8; ++i) S[i] = 0.f;
        for (int s = 0; s < 68; ++s) {
            const int cc = s < 4 ? s : s - 4;
            const int n = s < 4 ? 4 : 64, c = dir == 0 ? cc : n - 1 - cc;
            const int chunk = s < 4 ? (ML / 64 + b * 4 + c) : (b * 64 + c);
            bf16* slot = US + us_slot(chunk, h, dir) + (size_t)g8 * 8;
            const u32x4 uw = *(const u32x4*)slot;
            const float* dc = DC + ((size_t)(chunk * 4 + h) * 2 + dir) * 64 + dg;
            const f32x4 da = *(const f32x4*)dc, db = *(const f32x4*)(dc + 4);
            *(u32x4*)slot = (u32x4){pk2(S[0], S[1]), pk2(S[2], S[3]), pk2(S[4], S[5]), pk2(S[6], S[7])};
#pragma unroll
            for (int i = 0; i < 4; ++i) { S[2 * i] = (i < 2 ? da[2 * i] : db[2 * i - 4]) * S[2 * i] + bflo(uw[i]); S[2 * i + 1] = (i < 2 ? da[2 * i + 1] : db[2 * i - 3]) * S[2 * i + 1] + bfhi(uw[i]); }
        }
    }
}
__device__ __forceinline__ void phase_gla_out(const CAS DArgs& a, int l) {
    const int tid = fresh_tid(), lane = tid & 63, wave = __builtin_amdgcn_readfirstlane(tid >> 6); const int G = gridDim.x, wg = blockIdx.x; (void)tid;
    const bf16* P = (const bf16*)(AWS + WS_P); const bf16* US = (const bf16*)(AWS + WS_US); bf16* MIX = (bf16*)(AWS + WS_H);
    const float* gn = AIN(11) + (size_t)l * 128;
    const int fr = lane & 15, fq = lane >> 4, it = wave & 3;
    const int nunits = (l == 0 ? NCHUNK : ML / 64) * 4;
    for (int u = wg * 2 + (wave >> 2); u < nunits; u += G * 2) {
        const int chunk = u >> 2, h = u & 3;
        const int row = chunk * 64 + 16 * it + fr;
        const bf16* prow = P + (size_t)row * LDP;
        bf16x8 qf[2][2];
#pragma unroll
        for (int dr = 0; dr < 2; ++dr)
#pragma unroll
            for (int ks = 0; ks < 2; ++ks) qf[dr][ks] = *(const bf16x8*)(prow + (dr == 0 ? PQ : PK) + 64 * h + 32 * ks + 8 * fq);
        f32x4 acc[8]; float ss = 0.f;
#pragma unroll
        for (int et = 0; et < 8; ++et) {
            acc[et] = (f32x4){0.f, 0.f, 0.f, 0.f};
#pragma unroll
            for (int dr = 0; dr < 2; ++dr)
#pragma unroll
                for (int ks = 0; ks < 2; ++ks) { const bf16x8 sf = *(const bf16x8*)(US + us_slot(chunk, h, dr) + (size_t)(16 * et + fr) * 64 + 32 * ks + 8 * fq);
                    acc[et] = __builtin_amdgcn_mfma_f32_16x16x32_bf16(sf, qf[dr][ks], acc[et], 0, 0, 0); }
            const u32x2 oi = *(const u32x2*)(prow + PV + 128 * h + 16 * et + 4 * fq);
            acc[et][0] += bflo(oi.x); acc[et][1] += bfhi(oi.x); acc[et][2] += bflo(oi.y); acc[et][3] += bfhi(oi.y);
            ss += (acc[et][0] * acc[et][0] + acc[et][1] * acc[et][1]) + (acc[et][2] * acc[et][2] + acc[et][3] * acc[et][3]);
        }
        ss += __shfl_xor(ss, 16); ss += __shfl_xor(ss, 32);
        const float rs = 1.0f / sqrtf(ss * (1.0f / 128.0f) + EPS);
#pragma unroll
        for (int et = 0; et < 8; ++et) {
            const int e = 16 * et + 4 * fq;
            const u32x2 gg = *(const u32x2*)(prow + PGT + 128 * h + e);
            const f32x4 gv = *(const f32x4*)(gn + e);
            const float g0 = bflo(gg.x), g1 = bfhi(gg.x), g2 = bflo(gg.y), g3 = bfhi(gg.y);
            const float o0 = acc[et][0] * rs * gv[0] * pg8::silu_f(g0), o1 = acc[et][1] * rs * gv[1] * pg8::silu_f(g1), o2 = acc[et][2] * rs * gv[2] * pg8::silu_f(g2), o3 = acc[et][3] * rs * gv[3] * pg8::silu_f(g3);
            u32x2 w; w.x = pk2(o0, o1); w.y = pk2(o2, o3);
            *(u32x2*)(MIX + (size_t)row * D + 128 * h + e) = w;
        }
    }
}

constexpr int NPHASE = 29;
__global__ void __launch_bounds__(NTHR, 2) mk_fwd(Args args) {
    extern __shared__ __attribute__((aligned(16))) unsigned char lds_raw[];
    LAS unsigned char* lds = (LAS unsigned char*)lds_raw;
    const int tid = threadIdx.x, lane = tid & 63, wave = __builtin_amdgcn_readfirstlane(tid >> 6);
    const int G = gridDim.x, wg = blockIdx.x;
    const int vcu = (G % 8 == 0) ? (wg % 8) * (G / 8) + wg / 8 : wg;
    const int gw = vcu * NWAVES + wave, NGW = G * NWAVES;
    const CAS DArgs* kap = (const CAS DArgs*)__builtin_amdgcn_kernarg_segment_ptr();
#define KA() (*({ const CAS DArgs* _p = kap; asm volatile("" : "+s"(_p)); _p; }))
    unsigned char* ws = args.ws;
    for (int u = tid; u < (LDS_BYTES - LDSCTL_OFF) / 4; u += NTHR) ((LAS unsigned*)(lds + LDSCTL_OFF))[u] = 0u;
    __syncthreads();
    XcdBarrier bar; bar.bar = (unsigned*)(ws + WS_CTL) + CW_BAR; bar.x = 0; bar.st = nullptr;
#if !MK_PER_PHASE
    bar = xcd_barrier_post((unsigned*)(ws + WS_CTL) + CW_BAR, (volatile LAS unsigned*)(lds + LDSCTL_OFF));
#endif
    const int lo = args.ph_lo, hi = args.ph_hi;
#define IN(k) (lo <= (k) && (k) < hi)
#if MK_PER_PHASE
#define SEAM(k) do { } while (0)
#else
#define SEAM(k) do { if (IN(k) && IN((k) + 1)) { XcdBarrier b2_ = bar; asm volatile("" : "+s"(b2_.bar)); xcd_barrier(b2_); } } while (0)
#endif
#define WSP ((unsigned char*)KA().ws)
#define Hb ((bf16*)(WSP + WS_H))
#define Pb ((bf16*)(WSP + WS_P))

    if (IN(0)) { p0_prologue(KA(), lds); } SEAM(0);
    if (IN(1)) { phase_normmod0(KA()); } SEAM(1);

    for (int l = 0; l < 2; ++l) {
        const int pb = 9 * l;
        if (IN(2 + pb)) {
            pg8::Gemm g{Hb, (const bf16*)(WSP + WS_WIN) + (size_t)l * NPROJ * D, MT, NPROJ, D}; pg8::StaticOrder S; S.init(MT, NPROJ, G, wg);
            pg8::EpiInProj E{Pb, LDP};
            pg8::gemm_phase<pg8::EpiInProj, pg8::StaticOrder>(lds, g, S, E);
        } SEAM(2 + pb);
        if (IN(3 + pb)) { phase_gla_local(KA(), l, lds); phase_conv(KA(), l); } SEAM(3 + pb);
        if (IN(4 + pb)) { phase_gla_scan(KA()); } SEAM(4 + pb);
        if (IN(5 + pb)) { phase_gla_out(KA(), l); } SEAM(5 + pb);
        if (IN(6 + pb)) {
            const int M = l == 0 ? MT : ML;
            pg8::Gemm g{Hb, (const bf16*)(WSP + WS_WOUT) + (size_t)l * D * D, M, D, D}; pg8::StaticOrder S; S.init(M, D, G, wg);
            pg8::EpiPlain E{Pb, D};
            pg8::gemm_phase<pg8::EpiPlain, pg8::StaticOrder>(lds, g, S, E);
        } SEAM(6 + pb);
        if (IN(7 + pb)) { phase_postmix(KA(), l, lds); } SEAM(7 + pb);
        if (l == 0) {
            if (IN(8)) {
                pg8::Gemm g{Hb, (const bf16*)(WSP + WS_W13), MT, 2 * DFF, D}; pg8::StaticOrder S; S.init(MT, 2 * DFF, G, wg);
                pg8::EpiPair<1> E{Pb, DFF};
                pg8::gemm_phase<pg8::EpiPair<1>, pg8::StaticOrder>(lds, g, S, E);
            } SEAM(8);
            if (IN(9)) {
                pg8::Gemm g{Pb, (const bf16*)(WSP + WS_W2), MT, D, DFF}; pg8::StaticOrder S; S.init(MT, D, G, wg);
                pg8::EpiPlain E{Hb, D};
                pg8::gemm_phase<pg8::EpiPlain, pg8::StaticOrder>(lds, g, S, E);
            } SEAM(9);
            if (IN(10)) { phase_postffn0(KA()); } SEAM(10);
        }
    }
    if (IN(17)) { phase_gather(KA()); } SEAM(17);
    {
        unsigned cnt[8], off[9];
        const unsigned* ecnt = (const unsigned*)(WSP + WS_CTL) + CW_ECNT;
        if (hi > 18) {
#pragma unroll
            for (int e = 0; e < 8; ++e) cnt[e] = __hip_atomic_load(ecnt + e, __ATOMIC_RELAXED, __HIP_MEMORY_SCOPE_AGENT);
            expert_offsets(cnt, off);
        } else off[8] = 0u;
        const int ntiles = (int)(off[8] >> 8);
        for (int grp = 0; grp < MAXGROUPS; ++grp) {
            const int t0 = grp * GROUP_TILES; int nt = ntiles - t0; nt = nt > GROUP_TILES ? GROUP_TILES : nt;
            if (IN(18 + 2 * grp) && nt > 0) {
                pg8::Gemm g{Pb + (size_t)t0 * 256 * D, (const bf16*)(WSP + WS_E13), nt * 256, 2 * DFFE, D};
                pg8::MoeOrder S; S.init(nt * 256, 2 * DFFE, G, wg); S.texp = (const int*)(WSP + WS_TOK + TOK_TEXP) + t0; S.ebytes = (size_t)2 * DFFE * D * 2;
                pg8::EpiPair<1> E{(bf16*)(WSP + WS_HID_MOE), DFFE};
                pg8::gemm_phase<pg8::EpiPair<1>, pg8::MoeOrder>(lds, g, S, E);
            } SEAM(18 + 2 * grp);
            if (IN(19 + 2 * grp) && nt > 0) {
                pg8::Gemm g{(const bf16*)(WSP + WS_HID_MOE), (const bf16*)(WSP + WS_E2), nt * 256, D, DFFE};
                pg8::MoeOrder S; S.init(nt * 256, D, G, wg); S.texp = (const int*)(WSP + WS_TOK + TOK_TEXP) + t0; S.ebytes = (size_t)D * DFFE * 2;
                pg8::EpiPlain E{Pb + (size_t)t0 * 256 * D, D};
                pg8::gemm_phase<pg8::EpiPlain, pg8::MoeOrder>(lds, g, S, E);
            } SEAM(19 + 2 * grp);
        }
    }
    if (IN(28)) { phase_final(KA()); }
#undef Hb
#undef Pb
#undef WSP
#undef IN
#undef SEAM
}

extern "C" void kernel_launch(void* const* d_in, const int* in_sizes, int n_in, void* d_out, int out_size, void* d_ws, size_t ws_size, hipStream_t stream) {
    static int grid = 0;
    if (grid == 0) {
        if (n_in != 23 || out_size != ML * D || ws_size < WS_END) { fprintf(stderr, "kernel_launch: unexpected problem (n_in %d, out %d, ws %zu < %zu)\n", n_in, out_size, ws_size, (size_t)WS_END); grid = -1; return; }
        int dev = 0, cus = 0, per_cu = 0;
        if (hipGetDevice(&dev) != hipSuccess || hipDeviceGetAttribute(&cus, hipDeviceAttributeMultiprocessorCount, dev) != hipSuccess) { grid = -1; return; }
        if (hipFuncSetAttribute((const void*)mk_fwd, hipFuncAttributeMaxDynamicSharedMemorySize, LDS_BYTES) != hipSuccess) { fprintf(stderr, "kernel_launch: hipFuncSetAttribute failed\n"); grid = -1; return; }
        if (hipOccupancyMaxActiveBlocksPerMultiprocessor(&per_cu, (const void*)mk_fwd, NTHR, LDS_BYTES) != hipSuccess || per_cu < 1) { fprintf(stderr, "kernel_launch: occupancy query says %d\n", per_cu); }
        (void)hipGetLastError();
        grid = cus;
    }
    if (grid < 0) return;
    hipMemsetAsync((char*)d_ws + WS_CTL, 0, CTL_ZERO_BYTES, stream);
    Args a{};
    for (int i = 0; i < 23; ++i) a.in[i] = (const float*)d_in[i];
    a.out = (float*)d_out; a.ws = (unsigned char*)d_ws;
#if MK_PER_PHASE
    for (int p = 0; p < NPHASE; ++p) { a.ph_lo = p; a.ph_hi = p + 1; hipLaunchKernelGGL(mk_fwd, dim3(grid), dim3(NTHR), LDS_BYTES, stream, a); }
#else
    a.ph_lo = 0; a.ph_hi = NPHASE; hipLaunchKernelGGL(mk_fwd, dim3(grid), dim3(NTHR), LDS_BYTES, stream, a);
#endif
}
```

```cpp
#include <hip/hip_runtime.h>
#include <cstdio>
#include <cstdint>

#ifndef PROBE_MASK
#define PROBE_MASK 0u
#endif
#ifndef MK_PER_PHASE
#define MK_PER_PHASE 0
#endif

namespace pg8 {
#define PG8_LAS __attribute__((address_space(3)))
typedef unsigned short bf16_t;
typedef short bf16x8 __attribute__((ext_vector_type(8)));
typedef float f32x4 __attribute__((ext_vector_type(4)));
typedef unsigned u32x4 __attribute__((ext_vector_type(4)));
typedef unsigned u32x2 __attribute__((ext_vector_type(2)));
typedef int i32x4 __attribute__((ext_vector_type(4)));
typedef int i32x8 __attribute__((ext_vector_type(8)));
constexpr int BM = 256, BK = 64, HALF = 128, HTB = HALF * BK * 2, STAGE_BYTES = 8 * HTB, NXCD = 8, WGM = 8, RINGB = 131072;

__host__ __device__ __forceinline__ int lds_byte(int r, int c) { const int st = (r >> 4) * 2 + (c >> 5), rr = r & 15, cc = c & 31, ob = rr * 64 + cc * 2; return st * 1024 + (ob ^ (((ob >> 9) & 1) << 5)); }
__host__ __device__ __forceinline__ void stage_rc(int b, int& R, int& C) { const int st = b / 1024, sb = b % 1024, swz = sb ^ (((sb >> 9) & 1) << 5); R = (st >> 1) * 16 + swz / 64; C = (st & 1) * 32 + (swz % 64) / 2; }
__host__ __device__ __forceinline__ int perm32(int rho) { const int n = rho >> 4, i = rho & 15; return 8 * (i >> 2) + 4 * n + (i & 3); }

struct Unit { int pm, pn; };
template <bool INT> struct AccT { typedef f32x4 type; };
template <> struct AccT<true> { typedef i32x4 type; };
struct Gemm { const void* A; const void* Bt; int M, N, K; };

struct StaticOrder {
    int nM, nN, nwg, G, c;
    __host__ __device__ void init(int M, int N, int G_, int c_) { nM = M / BM; nN = N / BM; nwg = nM * nN; G = G_; c = c_; }
    __host__ __device__ bool next(int i, Unit& u) const {
        const long L = (long)i * G + c; if (L >= nwg) return false;
        int wgid = (int)L; { const int q = nwg / NXCD, r = nwg % NXCD, xcd = wgid % NXCD, off = wgid / NXCD; wgid = (xcd < r ? xcd * (q + 1) : r * (q + 1) + (xcd - r) * q) + off; }
        const int nig = WGM * nN, gid = wgid / nig, fm = gid * WGM, gsz = (nM - fm) < WGM ? (nM - fm) : WGM;
        u.pm = fm + ((wgid % nig) % gsz); u.pn = (wgid % nig) / gsz; return true;
    }
    __device__ __forceinline__ const char* bptr(const Gemm& g, const Unit& u, size_t tstep) const { return (const char*)g.Bt + (size_t)u.pn * tstep; }
    __device__ __forceinline__ void a_ready(const Unit&) const {}
    __device__ __forceinline__ void done(const Unit&) const {}
};
struct MoeOrder : StaticOrder {
    int t0; int toff[8]; size_t ebytes;
    __device__ __forceinline__ const char* bptr(const Gemm& g, const Unit& u, size_t tstep) const {
        const int t = t0 + u.pm; int e = 0;
#pragma unroll
        for (int q = 1; q < 8; ++q) e += (t >= toff[q]) ? 1 : 0;
        e = __builtin_amdgcn_readfirstlane(e);
        return (const char*)g.Bt + (size_t)e * ebytes + (size_t)u.pn * tstep; }
};

__device__ __forceinline__ unsigned cvt_pk_bf16(float lo, float hi) { unsigned r; asm volatile("v_cvt_pk_bf16_f32 %0, %1, %2" : "=v"(r) : "v"(lo), "v"(hi)); return r; }

struct EpiPlain {
    static constexpr bool PERM = true, AFTER_DRAIN = false, LDS_SCALES = false;
    bf16_t* O; int ldc; float sc = 1.0f;
    __device__ __forceinline__ void operator()(const f32x4 (&acc)[2][2][4][2], const Unit& u, int wr, int wc, int fr, int fq) const {
        const int row0 = u.pm * BM + wr * 64 + fr, col0 = u.pn * BM + wc * 32 + 8 * fq;
#pragma unroll
        for (int ai = 0; ai < 2; ++ai)
#pragma unroll
            for (int m = 0; m < 4; ++m) { bf16_t* rowp = O + (size_t)(row0 + ai * HALF + m * 16) * ldc + col0;
#pragma unroll
                for (int bj = 0; bj < 2; ++bj) { const f32x4 v0 = acc[ai][bj][m][0] * sc, v1 = acc[ai][bj][m][1] * sc;
                    u32x4 w; w.x = cvt_pk_bf16(v0[0], v0[1]); w.y = cvt_pk_bf16(v0[2], v0[3]); w.z = cvt_pk_bf16(v1[0], v1[1]); w.w = cvt_pk_bf16(v1[2], v1[3]);
                    *(u32x4*)(rowp + bj * HALF) = w; } }
    }
};
__device__ __forceinline__ unsigned pk4_fp8(float a, float b, float c, float d);
struct EpiPlainF8 {
    static constexpr bool PERM = true, AFTER_DRAIN = false, LDS_SCALES = false;
    unsigned char* O; int ldc; float sc;
    __device__ __forceinline__ void operator()(const f32x4 (&acc)[2][2][4][2], const Unit& u, int wr, int wc, int fr, int fq) const {
        const int row0 = u.pm * BM + wr * 64 + fr, col0 = u.pn * BM + wc * 32 + 8 * fq;
#pragma unroll
        for (int ai = 0; ai < 2; ++ai)
#pragma unroll
            for (int m = 0; m < 4; ++m) { unsigned char* rowp = O + (size_t)(row0 + ai * HALF + m * 16) * ldc + col0;
#pragma unroll
                for (int bj = 0; bj < 2; ++bj) { const f32x4 v0 = acc[ai][bj][m][0] * sc, v1 = acc[ai][bj][m][1] * sc;
                    u32x2 w; w.x = pk4_fp8(v0[0], v0[1], v0[2], v0[3]); w.y = pk4_fp8(v1[0], v1[1], v1[2], v1[3]);
                    *(u32x2*)(rowp + bj * HALF) = w; } }
    }
};
__device__ __forceinline__ float silu_f(float a) { return a * __builtin_amdgcn_rcpf(1.0f + __builtin_amdgcn_exp2f(-1.44269504f * a)); }
template <int ACT> struct EpiPair {
    static constexpr bool PERM = true, AFTER_DRAIN = false, LDS_SCALES = false;
    bf16_t* O; int ldc;
    __device__ __forceinline__ void operator()(const f32x4 (&acc)[2][2][4][2], const Unit& u, int wr, int wc, int fr, int fq) const {
        const int row0 = u.pm * BM + wr * 64 + fr, col0 = u.pn * HALF + wc * 32 + 8 * fq;
#pragma unroll
        for (int ai = 0; ai < 2; ++ai)
#pragma unroll
            for (int m = 0; m < 4; ++m) { bf16_t* rowp = O + (size_t)(row0 + ai * HALF + m * 16) * ldc + col0;
                f32x4 v0 = acc[ai][0][m][0], v1 = acc[ai][0][m][1]; const f32x4 g0 = acc[ai][1][m][0], g1 = acc[ai][1][m][1];
                if (ACT == 1) {
#pragma unroll
                    for (int j = 0; j < 4; ++j) { v0[j] = silu_f(v0[j]); v1[j] = silu_f(v1[j]); } }
                v0 = v0 * g0; v1 = v1 * g1;
                u32x4 w; w.x = cvt_pk_bf16(v0[0], v0[1]); w.y = cvt_pk_bf16(v0[2], v0[3]); w.z = cvt_pk_bf16(v1[0], v1[1]); w.w = cvt_pk_bf16(v1[2], v1[3]);
                *(u32x4*)rowp = w; }
    }
};
__device__ __forceinline__ unsigned pk4_fp8(float a, float b, float c, float d) {
    a = __builtin_amdgcn_fmed3f(a, -448.f, 448.f); b = __builtin_amdgcn_fmed3f(b, -448.f, 448.f); c = __builtin_amdgcn_fmed3f(c, -448.f, 448.f); d = __builtin_amdgcn_fmed3f(d, -448.f, 448.f);
    int w = 0; w = __builtin_amdgcn_cvt_pk_fp8_f32(a, b, w, false); w = __builtin_amdgcn_cvt_pk_fp8_f32(c, d, w, true); return (unsigned)w; }
struct EpiPairF8 {
    static constexpr bool PERM = true, AFTER_DRAIN = false, LDS_SCALES = false;
    unsigned char* O; int ldc; float sc;
    __device__ __forceinline__ void operator()(const f32x4 (&acc)[2][2][4][2], const Unit& u, int wr, int wc, int fr, int fq) const {
        const int row0 = u.pm * BM + wr * 64 + fr, col0 = u.pn * HALF + wc * 32 + 8 * fq;
        const float c1 = -1.44269504f * sc, c2 = sc * sc;
#pragma unroll
        for (int ai = 0; ai < 2; ++ai)
#pragma unroll
            for (int m = 0; m < 4; ++m) { unsigned char* rowp = O + (size_t)(row0 + ai * HALF + m * 16) * ldc + col0;
                u32x2 w;
#pragma unroll
                for (int n = 0; n < 2; ++n) {
                    const f32x4 A = acc[ai][0][m][n], B = acc[ai][1][m][n];
                    const f32x4 e = A * c1, num = (A * B) * c2;
                    f32x4 den;
#pragma unroll
                    for (int j = 0; j < 4; ++j) den[j] = __builtin_amdgcn_exp2f(e[j]);
                    den = den + 1.0f;
                    f32x4 o;
#pragma unroll
                    for (int j = 0; j < 4; ++j) o[j] = __builtin_amdgcn_rcpf(den[j]);
                    o = o * num;
                    w[n] = pk4_fp8(o[0], o[1], o[2], o[3]); }
                *(u32x2*)rowp = w; }
    }
};
constexpr int SCL_OFF = RINGB + 1024;
struct LdsScales {
    const float* sa; const float* sb; PG8_LAS unsigned char* lds;
    __device__ __forceinline__ void stage(const Unit& u, int par, int wid, int lane) const {
        const float* src = (wid < 4) ? sa + (size_t)u.pm * BM + wid * 64 + lane : sb + (size_t)u.pn * BM + (wid - 4) * 64 + lane;
        __builtin_amdgcn_global_load_lds((const unsigned*)src, (PG8_LAS unsigned*)(lds + SCL_OFF + par * 2048 + wid * 256), 4, 0, 0);
    }
    __device__ __forceinline__ float row_scale(int par, int rl) const { return *(const PG8_LAS float*)(lds + SCL_OFF + par * 2048 + rl * 4); }
    __device__ __forceinline__ f32x4 col_scale4(int par, int cl) const { return *(const PG8_LAS f32x4*)(lds + SCL_OFF + par * 2048 + 1024 + cl * 4); }
};
template <int OUT8> struct EpiPairI8 {
    static constexpr bool PERM = true, AFTER_DRAIN = false, LDS_SCALES = true;
    bf16_t* O; int ldc; LdsScales L;
    __device__ __forceinline__ void operator()(const i32x4 (&acc)[2][2][4][2], const Unit& u, int wr, int wc, int fr, int fq, int par) const {
        const int col0 = u.pn * HALF + wc * 32 + 8 * fq, cl0 = wc * 32 + 8 * fq;
        f32x4 c1[2], c2[2];
#pragma unroll
        for (int n = 0; n < 2; ++n) { const f32x4 sa = L.col_scale4(par, cl0 + 4 * n), sg = L.col_scale4(par, cl0 + HALF + 4 * n); c1[n] = sa * -1.44269504f; c2[n] = sa * sg; }
#pragma unroll
        for (int ai = 0; ai < 2; ++ai)
#pragma unroll
            for (int m = 0; m < 4; ++m) { const int rl = wr * 64 + fr + ai * HALF + m * 16; const float ra = L.row_scale(par, rl), ra2 = ra * ra;
                f32x4 o[2];
#pragma unroll
                for (int n = 0; n < 2; ++n) {
                    const f32x4 A = __builtin_convertvector(acc[ai][0][m][n], f32x4), G = __builtin_convertvector(acc[ai][1][m][n], f32x4);
                    const f32x4 e = A * (c1[n] * ra), num = (A * G) * (c2[n] * ra2);
                    f32x4 den;
#pragma unroll
                    for (int j = 0; j < 4; ++j) den[j] = __builtin_amdgcn_exp2f(e[j]);
                    den = den + 1.0f;
#pragma unroll
                    for (int j = 0; j < 4; ++j) o[n][j] = __builtin_amdgcn_rcpf(den[j]);
                    o[n] = o[n] * num; }
                if constexpr (OUT8) { u32x2 w; w.x = pk4_fp8(o[0][0], o[0][1], o[0][2], o[0][3]); w.y = pk4_fp8(o[1][0], o[1][1], o[1][2], o[1][3]);
                    *(u32x2*)((unsigned char*)O + (size_t)(u.pm * BM + rl) * ldc + col0) = w; }
                else { u32x4 w; w.x = cvt_pk_bf16(o[0][0], o[0][1]); w.y = cvt_pk_bf16(o[0][2], o[0][3]); w.z = cvt_pk_bf16(o[1][0], o[1][1]); w.w = cvt_pk_bf16(o[1][2], o[1][3]);
                    *(u32x4*)(O + (size_t)(u.pm * BM + rl) * ldc + col0) = w; } }
    }
};
struct EpiInProj {
    static constexpr bool PERM = true, AFTER_DRAIN = false, LDS_SCALES = false;
    bf16_t* O; int ldc;
    __device__ __forceinline__ void operator()(const f32x4 (&acc)[2][2][4][2], const Unit& u, int wr, int wc, int fr, int fq) const {
        if (u.pn >= 8 && u.pn < 12) { Unit v; v.pm = u.pm; v.pn = u.pn - 8; EpiPair<0> E{O + 2048, ldc}; E(acc, v, wr, wc, fr, fq); }
        else { Unit v; v.pm = u.pm; v.pn = (u.pn == 12) ? 10 : u.pn; EpiPlain E{O, ldc}; E(acc, v, wr, wc, fr, fq); }
    }
};

struct EpiInProjI8 {
    static constexpr bool PERM = true, AFTER_DRAIN = false, LDS_SCALES = true;
    bf16_t* O; int ldc; LdsScales L;
    __device__ __forceinline__ void operator()(const i32x4 (&acc)[2][2][4][2], const Unit& u, int wr, int wc, int fr, int fq, int par) const {
        const int cl0 = wc * 32 + 8 * fq;
        f32x4 sv[2][2];
#pragma unroll
        for (int bj = 0; bj < 2; ++bj)
#pragma unroll
            for (int n = 0; n < 2; ++n) sv[bj][n] = L.col_scale4(par, cl0 + bj * HALF + 4 * n);
        if (u.pn >= 8 && u.pn < 12) {
            const int col0 = 2048 + (u.pn - 8) * HALF + wc * 32 + 8 * fq;
#pragma unroll
            for (int ai = 0; ai < 2; ++ai)
#pragma unroll
                for (int m = 0; m < 4; ++m) { const int rl = wr * 64 + fr + ai * HALF + m * 16; bf16_t* rowp = O + (size_t)(u.pm * BM + rl) * ldc + col0; const float ra = L.row_scale(par, rl);
                    const float ra2 = ra * ra;
                    const f32x4 v0 = (__builtin_convertvector(acc[ai][0][m][0], f32x4) * __builtin_convertvector(acc[ai][1][m][0], f32x4)) * ((sv[0][0] * sv[1][0]) * ra2);
                    const f32x4 v1 = (__builtin_convertvector(acc[ai][0][m][1], f32x4) * __builtin_convertvector(acc[ai][1][m][1], f32x4)) * ((sv[0][1] * sv[1][1]) * ra2);
                    u32x4 w; w.x = cvt_pk_bf16(v0[0], v0[1]); w.y = cvt_pk_bf16(v0[2], v0[3]); w.z = cvt_pk_bf16(v1[0], v1[1]); w.w = cvt_pk_bf16(v1[2], v1[3]);
                    *(u32x4*)rowp = w; }
        } else {
            const int col0 = ((u.pn == 12) ? 10 : u.pn) * BM + wc * 32 + 8 * fq;
            const int nbj = (u.pn == 12) ? (wc == 0 ? 1 : 0) : 2;
#pragma unroll
            for (int ai = 0; ai < 2; ++ai)
#pragma unroll
                for (int m = 0; m < 4; ++m) { const int rl = wr * 64 + fr + ai * HALF + m * 16; bf16_t* rowp = O + (size_t)(u.pm * BM + rl) * ldc + col0; const float ra = L.row_scale(par, rl);
#pragma unroll
                    for (int bj = 0; bj < 2; ++bj) { if (bj >= nbj) continue;
                        const f32x4 v0 = __builtin_convertvector(acc[ai][bj][m][0], f32x4) * (sv[bj][0] * ra), v1 = __builtin_convertvector(acc[ai][bj][m][1], f32x4) * (sv[bj][1] * ra);
                        u32x4 w; w.x = cvt_pk_bf16(v0[0], v0[1]); w.y = cvt_pk_bf16(v0[2], v0[3]); w.z = cvt_pk_bf16(v1[0], v1[1]); w.w = cvt_pk_bf16(v1[2], v1[3]);
                        *(u32x4*)(rowp + bj * HALF) = w; } }
        }
    }
};

template <class Epi, class Sched, int MODE = 0  >
__device__ __forceinline__ void gemm_phase(PG8_LAS unsigned char* lds, const Gemm g, const Sched& S, const Epi& E) {
    constexpr bool ALIGN_EPI = true;
    int tid_ = threadIdx.x; asm volatile("" : "+v"(tid_));
    const int tid = tid_, wid = __builtin_amdgcn_readfirstlane(tid >> 6), lane = tid & 63, wr = wid >> 2, wc = wid & 3, fr = lane & 15, fq = lane >> 4;
    constexpr bool FP8 = (MODE == 1), I8 = (MODE == 2);
    const int K = (MODE != 0) ? g.K / 2 : g.K, nt = K / BK;
    unsigned voffA[2], voffB[2];
#pragma unroll
    for (int i = 0; i < 2; ++i) { int R, C; stage_rc(tid * 16 + i * 8192, R, C); const int Rb = Epi::PERM ? ((R & ~31) + perm32(R & 31)) : R;
        voffA[i] = (unsigned)(R * K + C) * 2u; voffB[i] = (unsigned)(Rb * K + C) * 2u; }
    const size_t kstep = (size_t)(BK * 2);
    const size_t hstep = (size_t)HALF * K * 2;
    const size_t tstep = 2 * hstep;
    const unsigned ldsw = (unsigned)wid * 1024u;
    const int aoff = lds_byte(wr * 64 + fr, fq * 8), boff = lds_byte(wc * 32 + fr, fq * 8);
#define PG8_SA(b, h) (((b) * 2 + (h)) * HTB)
#define PG8_SB(b, h) ((4 + (b) * 2 + (h)) * HTB)
#define PG8_STAGE(bufoff, gbase, voff) do { _Pragma("unroll") for (int _i = 0; _i < 2; ++_i) \
        __builtin_amdgcn_global_load_lds((const unsigned*)((const char*)(gbase) + (voff)[_i]), (PG8_LAS unsigned*)(lds + (bufoff) + ldsw + _i * 8192), 16, 0, 0); } while (0)
#define PG8_LDA(dst, b, h) do { _Pragma("unroll") for (int m = 0; m < 4; ++m) _Pragma("unroll") for (int k = 0; k < 2; ++k) dst[m][k] = *(const PG8_LAS bf16x8*)(lds + PG8_SA(b, h) + aoff + m * 2048 + k * 1024); } while (0)
#define PG8_LDB(dst, b, h) do { _Pragma("unroll") for (int n = 0; n < 2; ++n) _Pragma("unroll") for (int k = 0; k < 2; ++k) dst[n][k] = *(const PG8_LAS bf16x8*)(lds + PG8_SB(b, h) + boff + n * 2048 + k * 1024); } while (0)
#define PG8_MMA(ai, bj, At, Bt) do { __builtin_amdgcn_s_setprio(1); _Pragma("unroll") for (int m = 0; m < 4; ++m) _Pragma("unroll") for (int n = 0; n < 2; ++n) _Pragma("unroll") for (int k = 0; k < 2; ++k) \
        acc[ai][bj][m][n] = __builtin_amdgcn_mfma_f32_16x16x32_bf16(Bt[n][k], At[m][k], acc[ai][bj][m][n], 0, 0, 0); __builtin_amdgcn_s_setprio(0); } while (0)
#define PG8_MMA8(ai, bj, At, Bt) do { __builtin_amdgcn_s_setprio(1); _Pragma("unroll") for (int m = 0; m < 4; ++m) _Pragma("unroll") for (int n = 0; n < 2; ++n) { \
        const i32x8 bop_ = __builtin_shufflevector(__builtin_bit_cast(i32x4, Bt[n][0]), __builtin_bit_cast(i32x4, Bt[n][1]), 0, 1, 2, 3, 4, 5, 6, 7); \
        const i32x8 aop_ = __builtin_shufflevector(__builtin_bit_cast(i32x4, At[m][0]), __builtin_bit_cast(i32x4, At[m][1]), 0, 1, 2, 3, 4, 5, 6, 7); \
        asm volatile("v_mfma_scale_f32_16x16x128_f8f6f4 %0, %1, %2, %0, %3, %3 op_sel_hi:[0,0,0]" : "+v"(acc[ai][bj][m][n]) : "v"(bop_), "v"(aop_), "v"(scale1_)); } __builtin_amdgcn_s_setprio(0); } while (0)
#define PG8_MMAI(ai, bj, At, Bt) do { __builtin_amdgcn_s_setprio(1); _Pragma("unroll") for (int m = 0; m < 4; ++m) _Pragma("unroll") for (int n = 0; n < 2; ++n) _Pragma("unroll") for (int k = 0; k < 2; ++k) \
        acc[ai][bj][m][n] = __builtin_amdgcn_mfma_i32_16x16x64_i8(__builtin_bit_cast(i32x4, Bt[n][k]), __builtin_bit_cast(i32x4, At[m][k]), acc[ai][bj][m][n], 0, 0, 0); \
        __builtin_amdgcn_s_setprio(0); } while (0)
#define PG8_MM(ai, bj, At, Bt) do { if constexpr (FP8) PG8_MMA8(ai, bj, At, Bt); else if constexpr (I8) PG8_MMAI(ai, bj, At, Bt); else PG8_MMA(ai, bj, At, Bt); } while (0)
#define PG8_WAIT_V(n) asm volatile("s_waitcnt vmcnt(" #n ")" ::: "memory")
#define PG8_WAIT_L(n) asm volatile("s_waitcnt lgkmcnt(" #n ")" ::: "memory")
#define PG8_BAR __builtin_amdgcn_s_barrier()
#define PG8_SCHED __builtin_amdgcn_sched_barrier(0)
    Unit cur, nxt; int ui = 0;
    if (!S.next(0, cur)) return;
    int scale1_ = 0x7f7f7f7f; asm volatile("" : "+v"(scale1_)); (void)scale1_;
    typedef typename AccT<MODE == 2>::type acc_t;
    acc_t acc[2][2][4][2];
#pragma unroll
    for (int a = 0; a < 2; ++a)
#pragma unroll
        for (int b = 0; b < 2; ++b)
#pragma unroll
            for (int m = 0; m < 4; ++m)
#pragma unroll
                for (int n = 0; n < 2; ++n) acc[a][b][m][n] = (acc_t){0, 0, 0, 0};
    bf16x8 At[4][2], B0[2][2], B1[2][2];
    const char* cA = (const char*)g.A + (size_t)cur.pm * tstep; const char* cB = S.bptr(g, cur, tstep);
    S.a_ready(cur);
    if constexpr (Epi::LDS_SCALES) E.L.stage(cur, 0, wid, lane);
    PG8_STAGE(PG8_SB(0, 0), cB, voffB); PG8_STAGE(PG8_SB(0, 1), cB + hstep, voffB); PG8_STAGE(PG8_SA(0, 0), cA, voffA); PG8_STAGE(PG8_SA(0, 1), cA + hstep, voffA);
    if (wr == 1) PG8_BAR;
    PG8_WAIT_V(2); PG8_BAR;
    PG8_STAGE(PG8_SB(1, 0), cB + kstep, voffB); PG8_STAGE(PG8_SA(1, 0), cA + kstep, voffA); PG8_STAGE(PG8_SB(1, 1), cB + hstep + kstep, voffB);
    PG8_WAIT_V(6); PG8_BAR;
    for (;;) {
        const bool has_next = S.next(ui + 1, nxt);
        const char* nA = has_next ? (const char*)g.A + (size_t)nxt.pm * tstep : cA; const char* nB = has_next ? S.bptr(g, nxt, tstep) : cB;
        for (int t = 0; t < nt; t += 2) {
            const bool last = (t == nt - 2);
            const char* a1 = cA + (size_t)(t + 1) * kstep;
            const char* a2 = last ? nA : cA + (size_t)(t + 2) * kstep; const char* b2 = last ? nB : cB + (size_t)(t + 2) * kstep;
            const char* a3 = a2 + kstep; const char* b3 = b2 + kstep;
            if (last && has_next) S.a_ready(nxt);
            PG8_LDB(B0, 0, 0); PG8_LDB(B1, 0, 1); PG8_SCHED; PG8_LDA(At, 0, 0); PG8_STAGE(PG8_SA(1, 1), a1 + hstep, voffA);
            PG8_WAIT_V(8); PG8_WAIT_L(0); PG8_BAR; PG8_MM(0, 0, At, B0); PG8_MM(0, 1, At, B1); PG8_BAR; PG8_SCHED;
            PG8_LDA(At, 0, 1); PG8_STAGE(PG8_SB(0, 0), b2, voffB); PG8_STAGE(PG8_SB(0, 1), b2 + hstep, voffB); PG8_STAGE(PG8_SA(0, 0), a2, voffA);
            PG8_WAIT_V(8); PG8_WAIT_L(0); PG8_BAR; PG8_MM(1, 0, At, B0); PG8_MM(1, 1, At, B1); PG8_BAR; PG8_SCHED;
            PG8_LDB(B0, 1, 0); PG8_LDB(B1, 1, 1); PG8_SCHED; PG8_LDA(At, 1, 0); PG8_STAGE(PG8_SA(0, 1), a2 + hstep, voffA);
            PG8_WAIT_V(8); PG8_WAIT_L(0); PG8_BAR; PG8_MM(0, 0, At, B0); PG8_MM(0, 1, At, B1); PG8_BAR; PG8_SCHED;
            PG8_LDA(At, 1, 1); PG8_STAGE(PG8_SB(1, 0), b3, voffB); PG8_STAGE(PG8_SB(1, 1), b3 + hstep, voffB); PG8_STAGE(PG8_SA(1, 0), a3, voffA);
            PG8_WAIT_V(8); PG8_WAIT_L(0); PG8_BAR; PG8_MM(1, 0, At, B0); PG8_MM(1, 1, At, B1); PG8_BAR; PG8_SCHED;
        }
        if constexpr (ALIGN_EPI) { if (wr == 0) PG8_BAR; }
        if constexpr (FP8) asm volatile("s_nop 15\n\ts_nop 15" ::: "memory");
        if constexpr (Epi::LDS_SCALES) E(acc, cur, wr, wc, fr, fq, ui & 1); else E(acc, cur, wr, wc, fr, fq);
        S.done(cur);
        if (!has_next) break;
        if constexpr (Epi::LDS_SCALES) E.L.stage(nxt, (ui + 1) & 1, wid, lane);
#pragma unroll
        for (int a = 0; a < 2; ++a)
#pragma unroll
            for (int b = 0; b < 2; ++b)
#pragma unroll
                for (int m = 0; m < 4; ++m)
#pragma unroll
                    for (int n = 0; n < 2; ++n) { typedef unsigned long long u64x2_ __attribute__((ext_vector_type(2))); u64x2_ z;
                        asm volatile("v_mov_b64 %0, 0" : "=v"(z.x)); asm volatile("v_mov_b64 %0, 0" : "=v"(z.y)); acc[a][b][m][n] = __builtin_bit_cast(acc_t, z); }
        cur = nxt; cA = nA; cB = nB; ++ui;
        if constexpr (ALIGN_EPI) { if (wr == 1) PG8_BAR; }
    }
    PG8_WAIT_V(0);
    if constexpr (!ALIGN_EPI) { if (wr == 0) PG8_BAR; }
    PG8_BAR;
#undef PG8_SA
#undef PG8_SB
#undef PG8_STAGE
#undef PG8_LDA
#undef PG8_LDB
#undef PG8_MMA
#undef PG8_MMA8
#undef PG8_MMAI
#undef PG8_MM
#undef PG8_WAIT_V
#undef PG8_WAIT_L
#undef PG8_BAR
#undef PG8_SCHED
}
}

constexpr int NWAVES = 8, NTHR = 512;
constexpr int D = 1024, NB = 16, SEQ = 4096, CTXL = 256;
constexpr int ML = NB * SEQ;
constexpr int MC = NB * CTXL;
constexpr int MT = ML + MC;
constexpr int NPROJ_SRC = 3104;
constexpr int NPROJ = 3328;
constexpr int LDP = 2816;
constexpr int PQ = 0, PK = 256, PV = 512, PGT = 1024, PB = 1536, PU = 2048, PA = 2560;
constexpr int DFF = 2816, NEXP = 8, DFFE = 3584;
constexpr int NCHUNK = MT / 64;
constexpr int MAXSLOT = 2 * ML + NEXP * 256;
constexpr int MAXTILE = MAXSLOT / 256;
constexpr int GROUP_TILES = MAXTILE;
constexpr int MAXGROUPS = 1;
constexpr float EPS = 1e-6f;
constexpr float W13_SCALE = 64.0f, W2_SCALE = 128.0f;

constexpr size_t MiB = 1u << 20;
constexpr size_t WS_CTL = 0, CTL_ZERO_BYTES = 128 * 1024;
constexpr size_t WS_MOD = 1 * MiB;
constexpr size_t WS_DC = 2 * MiB;
constexpr size_t WS_TOK = 5 * MiB;
constexpr size_t WS_SA = 7 * MiB;
constexpr size_t WS_SB13 = 7 * MiB + 512 * 1024;
constexpr size_t WS_SBIN = 7 * MiB + 576 * 1024;
constexpr size_t WS_WIN = 8 * MiB;
constexpr size_t WS_WOUT = WS_WIN + (size_t)2 * NPROJ * D * 2;
constexpr size_t WS_W13 = WS_WOUT + (size_t)2 * D * D * 2;
constexpr size_t WS_W2 = WS_W13 + (size_t)2 * DFF * D * 2;
constexpr size_t WS_E13 = WS_W2 + (size_t)D * DFF * 2;
constexpr size_t WS_E2 = WS_E13 + (size_t)NEXP * 2 * DFFE * D;
constexpr size_t WS_XC = WS_E2 + (size_t)NEXP * D * DFFE;
constexpr size_t WS_H = WS_XC + (size_t)MC * D * 4;
constexpr size_t WS_US = WS_H + (size_t)MT * D * 2;
constexpr size_t WS_P = WS_US + (size_t)NCHUNK * 8 * 8192 * 2;
constexpr size_t WS_HID_MOE = WS_H;
constexpr size_t WS_YSLOT = WS_HID_MOE + (size_t)MAXSLOT * DFFE;
constexpr size_t WS_GATH = WS_YSLOT + (size_t)MAXSLOT * D * 2;
constexpr size_t WS_END = WS_GATH + (size_t)MAXSLOT * D;
constexpr size_t WS_U8 = WS_GATH;
static_assert((size_t)NCHUNK * 8 * 8192 <= (size_t)MAXSLOT * D, "U8 fits the gathered-row region");
static_assert(WS_GATH >= WS_P + (size_t)MT * LDP * 2, "gathered rows must not overlap the P region");
static_assert(WS_END <= (size_t)1024 * MiB, "workspace");
constexpr size_t TOK_E = 0;
constexpr size_t TOK_W = 256 * 1024;
constexpr size_t TOK_RANK = 768 * 1024;
constexpr size_t TOK_SLOT = 1280 * 1024;
constexpr size_t TOK_WGBASE = 1792 * 1024;
constexpr size_t TOK_TEXP = 1800 * 1024;
constexpr int CW_BAR = 4096;
constexpr int CW_ECNT = 8192;
constexpr int CW_CMAX13 = 16384;
constexpr int CW_CMAXIN = 24576;

static_assert((size_t)(CW_CMAXIN + 2 * NPROJ) * 4 <= CTL_ZERO_BYTES && (size_t)(CW_CMAX13 + 2 * DFF) * 4 <= (size_t)CW_CMAXIN * 4, "control words inside the per-call memset");
#define GAS __attribute__((address_space(1)))
#define CAS __attribute__((address_space(4)))
#define LAS __attribute__((address_space(3)))
typedef unsigned short bf16;
typedef float f32x4 __attribute__((ext_vector_type(4)));
typedef unsigned u32x4 __attribute__((ext_vector_type(4)));
typedef unsigned u32x2 __attribute__((ext_vector_type(2)));
typedef short bf16x8 __attribute__((ext_vector_type(8)));
#define LDS_WAIT() asm volatile("s_waitcnt lgkmcnt(0)" ::: "memory")
#define LDS_BARRIER() do { asm volatile("s_waitcnt lgkmcnt(0)" ::: "memory"); __builtin_amdgcn_s_barrier(); asm volatile("" ::: "memory"); } while (0)

__device__ __forceinline__ unsigned f2bf(float f) { unsigned u = __builtin_bit_cast(unsigned, f); return (u + 0x7fffu + ((u >> 16) & 1u)) >> 16; }
__device__ __forceinline__ unsigned pk2(float lo, float hi) { unsigned r; asm("v_cvt_pk_bf16_f32 %0, %1, %2" : "=v"(r) : "v"(lo), "v"(hi)); return r; }
__device__ __forceinline__ unsigned pk2_sw(float lo, float hi) { return f2bf(lo) | (f2bf(hi) << 16); }
__device__ __forceinline__ float bflo(unsigned w) { return __builtin_bit_cast(float, w << 16); }
__device__ __forceinline__ float bfhi(unsigned w) { return __builtin_bit_cast(float, w & 0xffff0000u); }
__device__ __forceinline__ float bf2f(unsigned short b) { return __builtin_bit_cast(float, ((unsigned)b) << 16); }
template <int CTRL, int RM> __device__ __forceinline__ float dpp0f(float v) { return __builtin_bit_cast(float, __builtin_amdgcn_update_dpp(0, __builtin_bit_cast(int, v), CTRL, RM, 0xf, true)); }
__device__ __forceinline__ float wave_sum(float v) {
    v += dpp0f<0x111, 0xf>(v); v += dpp0f<0x112, 0xf>(v); v += dpp0f<0x114, 0xf>(v); v += dpp0f<0x118, 0xf>(v);
    v += dpp0f<0x142, 0xa>(v); v += dpp0f<0x143, 0xc>(v);
    return __builtin_bit_cast(float, __builtin_amdgcn_readlane(__builtin_bit_cast(int, v), 63));
}
__device__ __forceinline__ float wave_max_nonneg(float v) {
    v = fmaxf(v, dpp0f<0x111, 0xf>(v)); v = fmaxf(v, dpp0f<0x112, 0xf>(v)); v = fmaxf(v, dpp0f<0x114, 0xf>(v)); v = fmaxf(v, dpp0f<0x118, 0xf>(v));
    v = fmaxf(v, dpp0f<0x142, 0xa>(v)); v = fmaxf(v, dpp0f<0x143, 0xc>(v));
    return __builtin_bit_cast(float, __builtin_amdgcn_readlane(__builtin_bit_cast(int, v), 63));
}

#define XB_TMO      128
#define XB_XCNT(j)  (256  + 64 * (j))
#define XB_XSUB(j)  (1280 + 64 * (j))
#define XB_XGEN(j)  (2304 + 64 * (j))
#define XB_TOP      3328
#define XB_TOPGEN   3392
#define XCD_BAR_WORDS 3456
#define XB_SPIN_CAP (1u << 22)
__device__ __forceinline__ unsigned xb_ld(unsigned* p)              { return __hip_atomic_load((GAS unsigned*)p, __ATOMIC_RELAXED, __HIP_MEMORY_SCOPE_AGENT); }
__device__ __forceinline__ unsigned xb_add(unsigned* p, unsigned v) { return __hip_atomic_fetch_add((GAS unsigned*)p, v, __ATOMIC_RELAXED, __HIP_MEMORY_SCOPE_AGENT); }
__device__ __forceinline__ unsigned xb_xcc_id() { return (unsigned)__builtin_amdgcn_s_getreg((3 << 11) | 20) & 0xFu; }
#define XB_SPIN(cond, bar) do { unsigned _sp = 0; while (cond) { __builtin_amdgcn_s_sleep(1); \
    if ((++_sp & 255u) == 0u) { if (xb_ld(&(bar)[XB_TMO])) break; if (_sp > XB_SPIN_CAP) { atomicAdd(&(bar)[XB_TMO], 1u); break; } } } } while (0)
struct XcdBarrier { unsigned* bar; unsigned x; volatile LAS unsigned* st; };
__device__ __forceinline__ XcdBarrier xcd_barrier_post(unsigned* bar, volatile LAS unsigned* st) {
    XcdBarrier b; b.bar = bar; b.x = xb_xcc_id(); b.st = st;
    if (threadIdx.x == 0) (void)xb_add(&bar[XB_XCNT(b.x)], 1u);
    return b;
}
__device__ __forceinline__ void xcd_barrier_complete(unsigned* bar, unsigned x, unsigned& nloc, unsigned& nx) {
    const unsigned G = gridDim.x * gridDim.y * gridDim.z;
    unsigned sum, cnt, mine, sp = 0u;
    for (;;) {
        sum = 0u; cnt = 0u; mine = 0u;
#pragma unroll
        for (unsigned j = 0; j < 16; ++j) { const unsigned c = xb_ld(&bar[XB_XCNT(j)]); sum += c; cnt += (c > 0u) ? 1u : 0u; mine = (j == x) ? c : mine; }
        if (sum == G) break;
        __builtin_amdgcn_s_sleep(1);
        if ((++sp & 255u) == 0u) { if (xb_ld(&bar[XB_TMO])) break; if (sp > XB_SPIN_CAP) { atomicAdd(&bar[XB_TMO], 1u); break; } }
    }
    nloc = mine > 0u ? mine : 1u; nx = cnt > 0u ? cnt : 1u;
}
__device__ __forceinline__ void xcd_barrier(const XcdBarrier& b) {
    asm volatile("s_waitcnt vmcnt(0)" ::: "memory");
    __syncthreads();
    if (threadIdx.x == 0) {
        unsigned* bar = b.bar;
        __builtin_amdgcn_s_waitcnt(0);
        unsigned nloc = b.st[0], nx = b.st[1];
        if (nloc == 0u) { xcd_barrier_complete(bar, b.x, nloc, nx); b.st[0] = nloc; b.st[1] = nx; }
        const unsigned old = xb_add(&bar[XB_XSUB(b.x)], 1u);
        const unsigned gen = old / nloc;
        if (old + 1u == (gen + 1u) * nloc) {
            __builtin_amdgcn_fence(__ATOMIC_RELEASE, "agent");
            asm volatile("s_waitcnt vmcnt(0)" ::: "memory");
            const unsigned og = xb_add(&bar[XB_TOP], 1u);
            const unsigned tg = og / nx;
            if (og + 1u == (tg + 1u) * nx) xb_add(&bar[XB_TOPGEN], 1u);
            else XB_SPIN(xb_ld(&bar[XB_TOPGEN]) == tg, bar);
            __builtin_amdgcn_fence(__ATOMIC_ACQUIRE, "agent");
            xb_add(&bar[XB_XGEN(b.x)], 1u);
            asm volatile("s_waitcnt vmcnt(0)" ::: "memory");
        } else {
            XB_SPIN(xb_ld(&bar[XB_XGEN(b.x)]) == gen, bar);
            __builtin_amdgcn_fence(__ATOMIC_ACQUIRE, "agent");
            asm volatile("s_waitcnt vmcnt(0)" ::: "memory");
        }
    }
    __syncthreads();
}

constexpr int RING_BYTES = 131072;
constexpr int LDSCTL_OFF = RING_BYTES;
constexpr int LDS_BYTES = 147456;

struct Args {
    const float* in[23]; float* out; unsigned char* ws; int ph_lo, ph_hi;
};
struct DArgs {
    const __attribute__((address_space(1))) float* in[23]; __attribute__((address_space(1))) float* out; __attribute__((address_space(1))) unsigned char* ws; int ph_lo, ph_hi;
};
static_assert(sizeof(Args) == sizeof(DArgs), "Args layout");

__device__ __forceinline__ int fresh_tid() { int t = threadIdx.x; asm volatile("" : "+v"(t)); return t; }
#define PHASE_IDS() const int tid = fresh_tid(), lane = tid & 63, wave = __builtin_amdgcn_readfirstlane(tid >> 6); const int G = gridDim.x, wg = blockIdx.x; \
    const int vcu = (G % 8 == 0) ? (wg % 8) * (G / 8) + wg / 8 : wg; const int gw = vcu * NWAVES + wave, NGW = G * NWAVES; (void)tid; (void)lane; (void)wave; (void)vcu; (void)gw; (void)NGW;
#define AIN(k) ((const float*)a.in[k])
#define AOUT ((float*)a.out)
#define AWS ((unsigned char*)a.ws)
struct Row { f32x4 v[4]; };
__device__ __forceinline__ Row ld_row_f32(const float* p, int lane) { Row r;
#pragma unroll
    for (int j = 0; j < 4; ++j) r.v[j] = *(const f32x4*)(p + 256 * j + 4 * lane);
    return r; }
__device__ __forceinline__ Row ld_row_bf16(const bf16* p, int lane) { Row r;
#pragma unroll
    for (int j = 0; j < 4; ++j) { const u32x2 w = *(const u32x2*)(p + 256 * j + 4 * lane); r.v[j] = (f32x4){bflo(w.x), bfhi(w.x), bflo(w.y), bfhi(w.y)}; }
    return r; }
__device__ __forceinline__ Row ld_row_fp8(const unsigned char* p, int lane) { Row r;
    typedef float f32x2_ __attribute__((ext_vector_type(2)));
#pragma unroll
    for (int j = 0; j < 4; ++j) { const int w = *(const int*)(p + 256 * j + 4 * lane); const f32x2_ a = __builtin_amdgcn_cvt_pk_f32_fp8(w, false), b = __builtin_amdgcn_cvt_pk_f32_fp8(w, true);
        r.v[j] = (f32x4){a.x, a.y, b.x, b.y}; }
    return r; }
__device__ __forceinline__ void st_row_f32(float* p, int lane, const Row& r) {
#pragma unroll
    for (int j = 0; j < 4; ++j) *(f32x4*)(p + 256 * j + 4 * lane) = r.v[j]; }
__device__ __forceinline__ void st_row_bf16(bf16* p, int lane, const Row& r) {
#pragma unroll
    for (int j = 0; j < 4; ++j) { u32x2 w; w.x = pk2(r.v[j][0], r.v[j][1]); w.y = pk2(r.v[j][2], r.v[j][3]); *(u32x2*)(p + 256 * j + 4 * lane) = w; } }
__device__ __forceinline__ void st_row_fp8(unsigned char* p, int lane, const Row& r) {
#pragma unroll
    for (int j = 0; j < 4; ++j) *(unsigned*)(p + 256 * j + 4 * lane) = pg8::pk4_fp8(r.v[j][0], r.v[j][1], r.v[j][2], r.v[j][3]); }
__device__ __forceinline__ float wave_max(float v) {
#pragma unroll
    for (int o = 1; o < 64; o <<= 1) v = fmaxf(v, __shfl_xor(v, o));
    return v;
}
__device__ __forceinline__ void st_row_i8(unsigned char* p, float* sa, int lane, const Row& r) {
    float mx = 0.f;
#pragma unroll
    for (int j = 0; j < 4; ++j) mx = fmaxf(fmaxf(mx, fmaxf(fabsf(r.v[j][0]), fabsf(r.v[j][1]))), fmaxf(fabsf(r.v[j][2]), fabsf(r.v[j][3])));
    mx = wave_max_nonneg(mx);
    const float inv = mx > 0.f ? 127.0f * __builtin_amdgcn_rcpf(mx) : 0.f;
#pragma unroll
    for (int j = 0; j < 4; ++j) {
        const unsigned t0 = __builtin_bit_cast(unsigned, __builtin_fmaf(r.v[j][0], inv, 12582912.0f)), t1 = __builtin_bit_cast(unsigned, __builtin_fmaf(r.v[j][1], inv, 12582912.0f));
        const unsigned t2 = __builtin_bit_cast(unsigned, __builtin_fmaf(r.v[j][2], inv, 12582912.0f)), t3 = __builtin_bit_cast(unsigned, __builtin_fmaf(r.v[j][3], inv, 12582912.0f));
        const unsigned p01 = __builtin_amdgcn_perm(t1, t0, 0x0c0c0400u), p23 = __builtin_amdgcn_perm(t3, t2, 0x0c0c0400u);
        *(unsigned*)(p + 256 * j + 4 * lane) = __builtin_amdgcn_perm(p23, p01, 0x05040100u); }
    (void)lane; *sa = mx > 0.f ? mx * (1.0f / 127.0f) : 1.0f;
}
__device__ __forceinline__ float row_rstd(const Row& r) { float s = 0.f;
#pragma unroll
    for (int j = 0; j < 4; ++j) s += (r.v[j][0] * r.v[j][0] + r.v[j][1] * r.v[j][1]) + (r.v[j][2] * r.v[j][2] + r.v[j][3] * r.v[j][3]);
    return __builtin_amdgcn_rsqf(wave_sum(s) * (1.0f / D) + EPS); }
#define XR(r) ((bf16*)((unsigned char*)AOUT + (size_t)(r) * 4096))
__device__ __forceinline__ const float* modp(const float* MOD, int l, int bb, int which) { return MOD + ((size_t)(l * 17 + bb) * 6 + which) * D; }
__device__ __forceinline__ int row_bb(int r) { return r < ML ? (r >> 12) : 16; }
struct RawB { u32x2 w[4]; };
struct RawF { u32x4 q[4]; };
__device__ __forceinline__ void ldraw_bf16(RawB& o, const bf16* p, int lane) {
#pragma unroll
    for (int j = 0; j < 4; ++j) o.w[j] = *(const u32x2*)(p + 256 * j + 4 * lane); }
__device__ __forceinline__ void ldraw_f32(RawF& o, const float* p, int lane) {
#pragma unroll
    for (int j = 0; j < 4; ++j) o.q[j] = *(const u32x4*)(p + 256 * j + 4 * lane); }
__device__ __forceinline__ void ldraw_bf16(RawF& o, const bf16* p, int lane) {
#pragma unroll
    for (int j = 0; j < 4; ++j) { const u32x2 w = *(const u32x2*)(p + 256 * j + 4 * lane); o.q[j].x = w.x; o.q[j].y = w.y; } }
__device__ __forceinline__ Row cvt_row(const RawB& i) { Row r;
#pragma unroll
    for (int j = 0; j < 4; ++j) r.v[j] = (f32x4){bflo(i.w[j].x), bfhi(i.w[j].x), bflo(i.w[j].y), bfhi(i.w[j].y)};
    return r; }
__device__ __forceinline__ Row cvt_row_f32(const RawF& i) { Row r;
#pragma unroll
    for (int j = 0; j < 4; ++j) r.v[j] = __builtin_bit_cast(f32x4, i.q[j]);
    return r; }
__device__ __forceinline__ Row cvt_row_bf16(const RawF& i) { Row r;
#pragma unroll
    for (int j = 0; j < 4; ++j) r.v[j] = (f32x4){bflo(i.q[j].x), bfhi(i.q[j].x), bflo(i.q[j].y), bfhi(i.q[j].y)};
    return r; }
#define ROWS3(LOAD, PROC, rb_, re_) do { int r = (rb_); const int rend_ = (re_), rl_ = rend_ - 1; LOAD(A, r); LOAD(B, (r + 1 < rl_ ? r + 1 : rl_)); \
        for (;;) { \
            LOAD(C, (r + 2 < rl_ ? r + 2 : rl_)); PROC(A, r); if (++r >= rend_) break; \
            LOAD(A, (r + 2 < rl_ ? r + 2 : rl_)); PROC(B, r); if (++r >= rend_) break; \
            LOAD(B, (r + 2 < rl_ ? r + 2 : rl_)); PROC(C, r); if (++r >= rend_) break; } } while (0)
__device__ __forceinline__ Row row_mul(const Row& a, const Row& b) { Row r;
#pragma unroll
    for (int j = 0; j < 4; ++j) r.v[j] = a.v[j] * b.v[j];
    return r; }
__device__ __forceinline__ Row row_mul1p(const Row& a, const Row& b) { Row r;
#pragma unroll
    for (int j = 0; j < 4; ++j) r.v[j] = a.v[j] * (1.0f + b.v[j]);
    return r; }
#define ROW_SEGMENTS(...) for (int rb = r_begin; rb < r_end; ) { const int bb = row_bb(rb); const int re0_ = bb < 16 ? (bb + 1) * 4096 : MT; const int re = re0_ < r_end ? re0_ : r_end; __VA_ARGS__; rb = re; }

__device__ __forceinline__ void transpose_item(const float* W, int K, int N, bf16* WT, int drow0, int k0, int n0, LAS float* scr, int lane) {
    float ld_[32];
#pragma unroll
    for (int i = 0; i < 32; ++i) ld_[i] = W[(size_t)(k0 + 2 * i + (lane >> 5)) * N + n0 + (lane & 31)];
#pragma unroll
    for (int i = 0; i < 32; ++i) scr[(2 * i + (lane >> 5)) * 33 + (lane & 31)] = ld_[i];
    LDS_WAIT(); asm volatile("" ::: "memory");
    const int c = lane & 7;
#pragma unroll
    for (int j = 0; j < 4; ++j) { const int n = (lane >> 3) + 8 * j; const LAS float* s = scr + (8 * c) * 33 + n;
        u32x4 o; o.x = pk2(s[0 * 33], s[1 * 33]); o.y = pk2(s[2 * 33], s[3 * 33]); o.z = pk2(s[4 * 33], s[5 * 33]); o.w = pk2(s[6 * 33], s[7 * 33]);
        *(u32x4*)(WT + (size_t)(drow0 + n) * K + k0 + 8 * c) = o; }
    LDS_WAIT(); asm volatile("" ::: "memory");
}
__device__ __forceinline__ unsigned pk4_fp8(float a, float b, float c, float d) { return pg8::pk4_fp8(a, b, c, d); }
__device__ __forceinline__ void transpose_item8(const float* W, int K, int N, unsigned char* WT, int drow0, int k0, int n0, float scale, LAS float* scr, int lane) {
    float ld_[32];
#pragma unroll
    for (int i = 0; i < 32; ++i) ld_[i] = W[(size_t)(k0 + 2 * i + (lane >> 5)) * N + n0 + (lane & 31)];
#pragma unroll
    for (int i = 0; i < 32; ++i) scr[(2 * i + (lane >> 5)) * 33 + (lane & 31)] = ld_[i];
    LDS_WAIT(); asm volatile("" ::: "memory");
    const int c = lane & 3;
#pragma unroll
    for (int j = 0; j < 2; ++j) { const int n = (lane >> 2) + 16 * j; const LAS float* sp = scr + (16 * c) * 33 + n;
        u32x4 o;
        o.x = pk4_fp8(sp[0 * 33] * scale, sp[1 * 33] * scale, sp[2 * 33] * scale, sp[3 * 33] * scale);
        o.y = pk4_fp8(sp[4 * 33] * scale, sp[5 * 33] * scale, sp[6 * 33] * scale, sp[7 * 33] * scale);
        o.z = pk4_fp8(sp[8 * 33] * scale, sp[9 * 33] * scale, sp[10 * 33] * scale, sp[11 * 33] * scale);
        o.w = pk4_fp8(sp[12 * 33] * scale, sp[13 * 33] * scale, sp[14 * 33] * scale, sp[15 * 33] * scale);
        *(u32x4*)(WT + (size_t)(drow0 + n) * K + k0 + 16 * c) = o; }
    LDS_WAIT(); asm volatile("" ::: "memory");
}
__device__ __forceinline__ void quant_strip_i8(const float* W, int K, int N, unsigned char* WT, float* SB, int drow0, int n0, LAS float* scr, int lane) {
    const float* wc = W + n0 + (lane & 31);
    float mx = 0.f;
    for (int k0 = 0; k0 < K; k0 += 64) {
        float ld_[32];
#pragma unroll
        for (int i = 0; i < 32; ++i) ld_[i] = wc[(size_t)(k0 + 2 * i + (lane >> 5)) * N];
#pragma unroll
        for (int i = 0; i < 32; ++i) mx = fmaxf(mx, fabsf(ld_[i]));
    }
    mx = fmaxf(mx, __shfl_xor(mx, 32));
    const float inv = mx > 0.f ? 127.0f / mx : 0.f;
    if (lane < 32) SB[drow0 + lane] = mx > 0.f ? mx * (1.0f / 127.0f) : 1.0f;
    for (int k0 = 0; k0 < K; k0 += 64) {
        float ld_[32];
#pragma unroll
        for (int i = 0; i < 32; ++i) ld_[i] = wc[(size_t)(k0 + 2 * i + (lane >> 5)) * N];
#pragma unroll
        for (int i = 0; i < 32; ++i) scr[(2 * i + (lane >> 5)) * 33 + (lane & 31)] = __builtin_rintf(ld_[i] * inv);
        LDS_WAIT(); asm volatile("" ::: "memory");
        const int c = lane & 3;
#pragma unroll
        for (int j = 0; j < 2; ++j) { const int n = (lane >> 2) + 16 * j; const LAS float* sp = scr + (16 * c) * 33 + n;
            unsigned o[4];
#pragma unroll
            for (int w = 0; w < 4; ++w) o[w] = ((unsigned)(int)sp[(4 * w) * 33] & 255u) | (((unsigned)(int)sp[(4 * w + 1) * 33] & 255u) << 8) | (((unsigned)(int)sp[(4 * w + 2) * 33] & 255u) << 16) | (((unsigned)(int)sp[(4 * w + 3) * 33] & 255u) << 24);
            *(u32x4*)(WT + (size_t)(drow0 + n) * K + k0 + 16 * c) = (u32x4){o[0], o[1], o[2], o[3]}; }
        LDS_WAIT(); asm volatile("" ::: "memory");
    }
}
__device__ __forceinline__ void colmax_item(const float* W, int N, unsigned* CMAX, int drow0, int k0, int n0, int lane) {
    float mx = 0.f;
#pragma unroll
    for (int i = 0; i < 32; ++i) mx = fmaxf(mx, fabsf(W[(size_t)(k0 + 2 * i + (lane >> 5)) * N + n0 + (lane & 31)]));
    mx = fmaxf(mx, __shfl_xor(mx, 32));
    if (lane < 32) atomicMax(CMAX + drow0 + lane, __builtin_bit_cast(unsigned, mx));
}
__device__ __forceinline__ void quant_item_i8(const float* W, int K, int N, unsigned char* WT, float* SB, const unsigned* CMAX, int drow0, int k0, int n0, LAS float* scr, int lane) {
    const float mx = __builtin_bit_cast(float, __hip_atomic_load(CMAX + drow0 + (lane & 31), __ATOMIC_RELAXED, __HIP_MEMORY_SCOPE_AGENT));
    const float inv = mx > 0.f ? 127.0f / mx : 0.f;
    if (k0 == 0 && lane < 32) SB[drow0 + lane] = mx > 0.f ? mx * (1.0f / 127.0f) : 1.0f;
    float ld_[32];
#pragma unroll
    for (int i = 0; i < 32; ++i) ld_[i] = W[(size_t)(k0 + 2 * i + (lane >> 5)) * N + n0 + (lane & 31)];
#pragma unroll
    for (int i = 0; i < 32; ++i) scr[(2 * i + (lane >> 5)) * 33 + (lane & 31)] = __builtin_rintf(ld_[i] * inv);
    LDS_WAIT(); asm volatile("" ::: "memory");
    const int c = lane & 3;
#pragma unroll
    for (int j = 0; j < 2; ++j) { const int n = (lane >> 2) + 16 * j; const LAS float* sp = scr + (16 * c) * 33 + n;
        unsigned o[4];
#pragma unroll
        for (int w = 0; w < 4; ++w) o[w] = ((unsigned)(int)sp[(4 * w) * 33] & 255u) | (((unsigned)(int)sp[(4 * w + 1) * 33] & 255u) << 8) | (((unsigned)(int)sp[(4 * w + 2) * 33] & 255u) << 16) | (((unsigned)(int)sp[(4 * w + 3) * 33] & 255u) << 24);
        *(u32x4*)(WT + (size_t)(drow0 + n) * K + k0 + 16 * c) = (u32x4){o[0], o[1], o[2], o[3]}; }
    LDS_WAIT(); asm volatile("" ::: "memory");
}
__device__ __forceinline__ int win_drow(int n0) {
    if (n0 < 1536) return n0;
    if (n0 < 1568) return 3072 + (n0 - 1536);
    if (n0 < 2080) return 1536 + (n0 - 1568);
    if (n0 < 2592) { const int j = n0 - 2080; return 2048 + (j >> 7) * 256 + (j & 127); }
    { const int j = n0 - 2592; return 2048 + (j >> 7) * 256 + 128 + (j & 127); }
}
__device__ __forceinline__ int pair_drow(int n0, int second) { return (n0 >> 7) * 256 + second * 128 + (n0 & 127); }

__device__ __forceinline__ void p0_prologue(const CAS DArgs& a, LAS unsigned char* lds) {
    PHASE_IDS();
    unsigned char* ws = AWS;
    {
        LAS float* sc = (LAS float*)lds;
        LAS float* part = (LAS float*)(lds + 17 * 1024 * 4);
        const float* c = AIN(1); const float* cc = AIN(3);
        bool filled = false;
        for (int t = vcu; t < 192; t += G) {
            if (!filled) {
                for (int i = tid; i < 17 * 1024; i += NTHR) { const float v = (i < 16 * 1024) ? c[i] : cc[i - 16 * 1024]; sc[i] = v / (1.0f + __expf(-v)); }
                __syncthreads(); filled = true;
            }
            const int l = t / 96, cb = t % 96, col = cb * 64 + lane;
            const float* wm = AIN(4) + (size_t)l * D * 6144 + col;
            float acc[17];
#pragma unroll
            for (int b = 0; b < 17; ++b) acc[b] = 0.f;
            for (int k = wave * 128; k < wave * 128 + 128; k += 4) {
                float w[4];
#pragma unroll
                for (int q = 0; q < 4; ++q) w[q] = wm[(size_t)(k + q) * 6144];
#pragma unroll
                for (int q = 0; q < 4; ++q)
#pragma unroll
                    for (int b = 0; b < 17; ++b) acc[b] += sc[b * 1024 + k + q] * w[q];
            }
#pragma unroll
            for (int b = 0; b < 17; ++b) part[(wave * 17 + b) * 64 + lane] = acc[b];
            __syncthreads();
            for (int i = tid; i < 17 * 64; i += NTHR) { const int b = i / 64, cl = i % 64; float s = AIN(5)[(size_t)l * 6144 + cb * 64 + cl];
#pragma unroll
                for (int w = 0; w < 8; ++w) s += part[(w * 17 + b) * 64 + cl];
                const int j = cb * 64 + cl;
                ((float*)(ws + WS_MOD))[((size_t)(l * 17 + b) * 6 + (j >> 10)) * D + (j & 1023)] = s; }
            __syncthreads();
        }
        __syncthreads();
    }
    LAS float* scr = (LAS float*)(lds + wave * 16384);
    for (int it = gw; it < 2 * 16 * 88; it += NGW) { const int sec = it / (16 * 88), r = it % (16 * 88), kb = r / 88, nb = r % 88;
        colmax_item(sec ? AIN(17) : AIN(16), DFF, (unsigned*)(ws + WS_CTL) + CW_CMAX13, pair_drow(nb * 32, sec), kb * 64, nb * 32, lane); }
    constexpr int I_IN = 16 * 97, I_OUT = 16 * 32, I_W2 = 44 * 32;
    constexpr int T0 = 2 * I_IN, T1 = T0 + 2 * I_OUT, T3 = T1 + I_W2;
    for (int it = gw; it < T3; it += NGW) {
        if (it < T0) { const int l = it / I_IN, r = it % I_IN, kb = r / 97, nb = r % 97;
            colmax_item(AIN(8) + (size_t)l * D * NPROJ_SRC, NPROJ_SRC, (unsigned*)(ws + WS_CTL) + CW_CMAXIN + l * NPROJ, win_drow(nb * 32), kb * 64, nb * 32, lane); }
        else if (it < T1) { const int q = it - T0, l = q / I_OUT, r = q % I_OUT, kb = r / 32, nb = r % 32;
            transpose_item(AIN(13) + (size_t)l * D * D, D, D, (bf16*)(ws + WS_WOUT) + (size_t)l * D * D, nb * 32, kb * 64, nb * 32, scr, lane); }
        else { const int r = it - T1, kb = r / 32, nb = r % 32;
            transpose_item8(AIN(18), DFF, D, ws + WS_W2, nb * 32, kb * 64, nb * 32, W2_SCALE, scr, lane); }
    }
    for (int i = gw * 64 + lane; i < 2 * 224 * 64; i += NGW * 64) { const int l = i / (224 * 64), r = i % (224 * 64);
        *(u32x4*)(ws + WS_WIN + (size_t)l * NPROJ * D + (size_t)3104 * D + (size_t)r * 16) = (u32x4){0u, 0u, 0u, 0u}; }
    for (int i = gw * 64 + lane; i < 2 * 224; i += NGW * 64) ((float*)(ws + WS_SBIN))[(i / 224) * NPROJ + 3104 + i % 224] = 1.0f;
}
__device__ __forceinline__ void convert_expert_weights(const CAS DArgs& a, LAS unsigned char* lds, int rank, int nranks, int part  ) {
    const int tid = fresh_tid(), lane = tid & 63, wave = __builtin_amdgcn_readfirstlane(tid >> 6);
    unsigned char* ws = AWS; LAS float* scr = (LAS float*)(lds + wave * 16384);
    constexpr int I_E1 = 16 * 112, I_E2 = 56 * 32, T4 = 16 * I_E1, T5 = T4 + 8 * I_E2;
    for (int it = (part ? T4 : 0) + rank; it < (part ? T5 : T4); it += nranks) {
        if (it < T4) { const int es = it / I_E1, e = es >> 1, s = es & 1, r = it % I_E1, kb = r / 112, nb = r % 112;
            transpose_item8((s ? AIN(21) : AIN(20)) + (size_t)e * D * DFFE, D, DFFE, ws + WS_E13 + (size_t)e * 2 * DFFE * D, pair_drow(nb * 32, s), kb * 64, nb * 32, W13_SCALE, scr, lane); }
        else { const int q = it - T4, e = q / I_E2, r = q % I_E2, kb = r / 32, nb = r % 32;
            transpose_item8(AIN(22) + (size_t)e * DFFE * D, DFFE, D, ws + WS_E2 + (size_t)e * D * DFFE, nb * 32, kb * 64, nb * 32, W2_SCALE, scr, lane); }
    }
}
#define ROW_BLOCK(nrows) const int RPW_ = ((nrows) + NGW - 1) / NGW; const int r_begin = gw * RPW_; const int r_end = (r_begin + RPW_ < (nrows)) ? r_begin + RPW_ : (nrows);
__device__ __forceinline__ int row_owner_wg(int r, int nrows, int NGW) { const int rpw = (nrows + NGW - 1) / NGW; return (r / rpw) / NWAVES; }

__device__ __forceinline__ void quantize_weights(const CAS DArgs& a, LAS unsigned char* lds) {
    PHASE_IDS();
    unsigned char* ws = AWS; LAS float* scr = (LAS float*)(lds + wave * 16384);
    for (int it = gw; it < 2 * 16 * 88; it += NGW) { const int sec = it / (16 * 88), r = it % (16 * 88), kb = r / 88, nb = r % 88;
        quant_item_i8(sec ? AIN(17) : AIN(16), D, DFF, ws + WS_W13, (float*)(ws + WS_SB13), (const unsigned*)(ws + WS_CTL) + CW_CMAX13, pair_drow(nb * 32, sec), kb * 64, nb * 32, scr, lane); }
    for (int it = gw; it < 2 * 16 * 97; it += NGW) { const int l = it / (16 * 97), r = it % (16 * 97), kb = r / 97, nb = r % 97;
        quant_item_i8(AIN(8) + (size_t)l * D * NPROJ_SRC, D, NPROJ_SRC, ws + WS_WIN + (size_t)l * NPROJ * D, (float*)(ws + WS_SBIN) + l * NPROJ, (const unsigned*)(ws + WS_CTL) + CW_CMAXIN + l * NPROJ, win_drow(nb * 32), kb * 64, nb * 32, scr, lane); }
}
__device__ __forceinline__ void phase_normmod0(const CAS DArgs& a) {
    const int tid = fresh_tid(), lane = tid & 63, wave = __builtin_amdgcn_readfirstlane(tid >> 6); const int G = gridDim.x, wg = blockIdx.x;
    const int gw = wg * NWAVES + wave, NGW = G * NWAVES;
    const float* MOD = (const float*)(AWS + WS_MOD); bf16* H = (bf16*)(AWS + WS_H);
    ROW_BLOCK(MT);
    if (r_begin >= r_end) return;
    const Row g = ld_row_f32(AIN(6), lane);
#define SRC0(r) ((r) < ML ? AIN(0) + (size_t)(r) * D : AIN(2) + (size_t)((r) - ML) * D)
    RawF xA, xB, xC;
#define NM_LOAD(S, rr) do { const int r_ = (rr); ldraw_f32(x##S, SRC0(r_), lane); } while (0)
#define NM_PROC(S, rr) do { const int r_ = (rr); Row x = cvt_row_f32(x##S); \
        const float rs = row_rstd(x); \
        _Pragma("unroll") for (int j = 0; j < 4; ++j) x.v[j] = (x.v[j] * rs) * gs.v[j] + sh.v[j]; \
        st_row_i8((unsigned char*)H + (size_t)r_ * D, (float*)(AWS + WS_SA) + r_, lane, x); \
    } while (0)
    ROW_SEGMENTS({ const Row gs = row_mul1p(g, ld_row_f32(modp(MOD, 0, bb, 1), lane)), sh = ld_row_f32(modp(MOD, 0, bb, 0), lane); ROWS3(NM_LOAD, NM_PROC, rb, re); });
#undef NM_LOAD
#undef NM_PROC
}
__device__ __forceinline__ void postmix_route(const CAS DArgs& a, const Row& x, int r, int lane, LAS float* wr_l, LAS unsigned* lcnt) {
    f32x4 la = (f32x4){0.f, 0.f, 0.f, 0.f}, lb = (f32x4){0.f, 0.f, 0.f, 0.f};
#pragma unroll
    for (int j = 0; j < 4; ++j)
#pragma unroll
        for (int q = 0; q < 4; ++q) { const LAS f32x4* wp = (const LAS f32x4*)(wr_l + (256 * j + 4 * lane + q) * 8); const float xv = x.v[j][q]; la += wp[0] * xv; lb += wp[1] * xv; }
    float lg[8];
#pragma unroll
    for (int e = 0; e < 4; ++e) { lg[e] = la[e]; lg[4 + e] = lb[e]; }
#define RT_STEP(CTRL, RM) _Pragma("unroll") for (int e = 0; e < 8; ++e) lg[e] += dpp0f<CTRL, RM>(lg[e]);
    RT_STEP(0x111, 0xf) RT_STEP(0x112, 0xf) RT_STEP(0x114, 0xf) RT_STEP(0x118, 0xf) RT_STEP(0x142, 0xa) RT_STEP(0x143, 0xc)
#undef RT_STEP
#pragma unroll
    for (int e = 0; e < 8; ++e) lg[e] = __builtin_bit_cast(float, __builtin_amdgcn_readlane(__builtin_bit_cast(int, lg[e]), 63));
    int e0 = 0; float v0 = lg[0];
#pragma unroll
    for (int e = 1; e < 8; ++e) if (lg[e] > v0) { v0 = lg[e]; e0 = e; }
    int e1 = -1; float v1 = -3.0e38f;
#pragma unroll
    for (int e = 0; e < 8; ++e) if (e != e0 && lg[e] > v1) { v1 = lg[e]; e1 = e; }
    if (lane == 0) {
        const float w1 = __builtin_amdgcn_rcpf(1.0f + __builtin_amdgcn_exp2f((v0 - v1) * 1.44269504f)), w0 = 1.0f - w1;
        const unsigned r0 = __hip_atomic_fetch_add(lcnt + e0, 1u, __ATOMIC_RELAXED, __HIP_MEMORY_SCOPE_WORKGROUP), r1 = __hip_atomic_fetch_add(lcnt + e1, 1u, __ATOMIC_RELAXED, __HIP_MEMORY_SCOPE_WORKGROUP);
        unsigned char* tk = AWS + WS_TOK;
        ((unsigned*)(tk + TOK_E))[r] = (unsigned)e0 | ((unsigned)e1 << 8);
        ((float*)(tk + TOK_W))[2 * r] = w0; ((float*)(tk + TOK_W))[2 * r + 1] = w1;
        ((unsigned*)(tk + TOK_RANK))[2 * r] = r0; ((unsigned*)(tk + TOK_RANK))[2 * r + 1] = r1;
    }
}
template <int l> __device__ __forceinline__ void phase_postmix(const CAS DArgs& a, LAS unsigned char* lds) {
    const int tid = fresh_tid(), lane = tid & 63, wave = __builtin_amdgcn_readfirstlane(tid >> 6); const int G = gridDim.x, wg = blockIdx.x;
    const float* MOD = (const float*)(AWS + WS_MOD); bf16* H = (bf16*)(AWS + WS_H); const bf16* Y = (const bf16*)(AWS + WS_P);
    float* XC = (float*)(AWS + WS_XC);
    constexpr int nrows = l == 0 ? MT : ML;
    const int gw = wg * NWAVES + wave, NGW = G * NWAVES;
    LAS float* wr_l = (LAS float*)lds;
    LAS unsigned* lcnt = (LAS unsigned*)(lds + LDSCTL_OFF + 64);
    if (l == 1) {
        for (int i = tid; i < D * NEXP; i += NTHR) wr_l[i] = AIN(19)[i];
        if (tid < 8) lcnt[tid] = 0u;
        __syncthreads();
    }
    ROW_BLOCK(nrows);
    if (r_begin < r_end) {
    const Row gpo = ld_row_f32(AIN(7) + (size_t)l * D, lane), gpr = ld_row_f32(AIN(14) + (size_t)l * D, lane);
    RawB yA, yB, yC; RawF xA, xB, xC;
#define PM_LOAD(S, rr) do { const int r_ = (rr); ldraw_bf16(y##S, Y + (size_t)r_ * D, lane); if constexpr (l == 0) ldraw_f32(x##S, SRC0(r_), lane); else ldraw_bf16(x##S, XR(r_), lane); } while (0)
#define PM_PROC(S, rr, LAT) do { const int r_ = (rr); const Row y = cvt_row(y##S); Row x; if constexpr (l == 0) x = cvt_row_f32(x##S); else x = cvt_row_bf16(x##S); \
        const float rs = row_rstd(y); \
        _Pragma("unroll") for (int j = 0; j < 4; ++j) x.v[j] = x.v[j] + gg.v[j] * (y.v[j] * rs); \
        if (LAT) st_row_bf16(XR(r_), lane, x); else st_row_f32(XC + (size_t)(r_ - ML) * D, lane, x); \
        const float rs2 = row_rstd(x); \
        _Pragma("unroll") for (int j = 0; j < 4; ++j) x.v[j] = (x.v[j] * rs2) * gs.v[j] + sh.v[j]; \
        if constexpr (l == 0) st_row_i8((unsigned char*)H + (size_t)r_ * D, (float*)(AWS + WS_SA) + r_, lane, x); else st_row_fp8((unsigned char*)H + (size_t)r_ * D, lane, x); \
        if constexpr (l == 1) postmix_route(a, x, r_, lane, wr_l, lcnt); \
    } while (0)
#define PM_PROC_L(S, rr) PM_PROC(S, rr, 1)
#define PM_PROC_C(S, rr) PM_PROC(S, rr, 0)
    ROW_SEGMENTS({ const Row gg = row_mul(ld_row_f32(modp(MOD, l, bb, 2), lane), gpo), gs = row_mul1p(gpr, ld_row_f32(modp(MOD, l, bb, 4), lane)), sh = ld_row_f32(modp(MOD, l, bb, 3), lane);
        if (bb < 16) ROWS3(PM_LOAD, PM_PROC_L, rb, re); else ROWS3(PM_LOAD, PM_PROC_C, rb, re); });
#undef PM_PROC_L
#undef PM_PROC_C
#undef PM_LOAD
#undef PM_PROC
    }
    if (l == 1) {
        __syncthreads();
        if (tid < 8) { const unsigned n = lcnt[tid];
            const unsigned base = __hip_atomic_fetch_add((unsigned*)(AWS + WS_CTL) + CW_ECNT + tid, n, __ATOMIC_RELAXED, __HIP_MEMORY_SCOPE_AGENT);
            ((unsigned*)(AWS + WS_TOK + TOK_WGBASE))[wg * 8 + tid] = base; }
        __syncthreads();
    }
}
__device__ __forceinline__ void phase_postffn0(const CAS DArgs& a) {
    const int tid = fresh_tid(), lane = tid & 63, wave = __builtin_amdgcn_readfirstlane(tid >> 6); const int G = gridDim.x, wg = blockIdx.x;
    const int gw = wg * NWAVES + wave, NGW = G * NWAVES;
    const float* MOD = (const float*)(AWS + WS_MOD); bf16* H = (bf16*)(AWS + WS_H); float* XC = (float*)(AWS + WS_XC);
    ROW_BLOCK(MT);
    if (r_begin >= r_end) return;
    const Row gpo = ld_row_f32(AIN(15), lane), gpr = ld_row_f32(AIN(6) + D, lane);
    RawB yA, yB, yC; RawF xA, xB, xC;
#define PF_LOAD(S, rr, LAT) do { const int r_ = (rr); ldraw_bf16(y##S, H + (size_t)r_ * D, lane); if (LAT) ldraw_bf16(x##S, XR(r_), lane); else ldraw_f32(x##S, XC + (size_t)(r_ - ML) * D, lane); } while (0)
#define PF_PROC(S, rr, LAT) do { const int r_ = (rr); const Row y = cvt_row(y##S); Row x = (LAT) ? cvt_row_bf16(x##S) : cvt_row_f32(x##S); \
        const float rs = row_rstd(y); \
        _Pragma("unroll") for (int j = 0; j < 4; ++j) x.v[j] = x.v[j] + gg.v[j] * (y.v[j] * rs); \
        if (LAT) st_row_bf16(XR(r_), lane, x); else st_row_f32(XC + (size_t)(r_ - ML) * D, lane, x); \
        const float rs2 = row_rstd(x); \
        _Pragma("unroll") for (int j = 0; j < 4; ++j) x.v[j] = (x.v[j] * rs2) * gs.v[j] + sh.v[j]; \
        st_row_i8(AWS + WS_US + (size_t)r_ * D, (float*)(AWS + WS_SA) + r_, lane, x);        \
    } while (0)
#define PF_LOAD_L(S, rr) PF_LOAD(S, rr, 1)
#define PF_PROC_L(S, rr) PF_PROC(S, rr, 1)
#define PF_LOAD_C(S, rr) PF_LOAD(S, rr, 0)
#define PF_PROC_C(S, rr) PF_PROC(S, rr, 0)
    ROW_SEGMENTS({ const Row gg = row_mul(ld_row_f32(modp(MOD, 0, bb, 5), lane), gpo), gs = row_mul1p(gpr, ld_row_f32(modp(MOD, 1, bb, 1), lane)), sh = ld_row_f32(modp(MOD, 1, bb, 0), lane);
        if (bb < 16) ROWS3(PF_LOAD_L, PF_PROC_L, rb, re); else ROWS3(PF_LOAD_C, PF_PROC_C, rb, re); });
#undef PF_LOAD_L
#undef PF_PROC_L
#undef PF_LOAD_C
#undef PF_PROC_C
#undef PF_LOAD
#undef PF_PROC
}
__device__ __forceinline__ void phase_final(const CAS DArgs& a) {
    const int tid = fresh_tid(), lane = tid & 63, wave = __builtin_amdgcn_readfirstlane(tid >> 6); const int G = gridDim.x, wg = blockIdx.x;
    const int gw = wg * NWAVES + wave, NGW = G * NWAVES;
    const float* MOD = (const float*)(AWS + WS_MOD); const unsigned char* YS = AWS + WS_YSLOT;
    const unsigned char* tk = AWS + WS_TOK;
    const int RPW_ = (ML + NGW - 1) / NGW; const int blk_begin = gw * RPW_; const int blk_end = (blk_begin + RPW_ < ML) ? blk_begin + RPW_ : ML;
    if (blk_begin >= blk_end) return;
    const Row g = ld_row_f32(AIN(15) + D, lane);
    for (int r_begin = blk_begin; r_begin < blk_end; r_begin += 64) { const int r_end = (r_begin + 64 < blk_end) ? r_begin + 64 : blk_end;
    const int nr = r_end - r_begin;
    u32x2 myslot = (u32x2){0u, 0u}; u32x2 mywt = (u32x2){0u, 0u};
    if (lane < nr) { myslot = ((const u32x2*)(tk + TOK_SLOT))[r_begin + lane]; mywt = ((const u32x2*)(tk + TOK_W))[r_begin + lane]; }
    struct Raw8 { unsigned w[4]; };
    Raw8 pA, pB, pC, qA, qB, qC; RawB xA, xB, xC;
#define FN_LOAD(S, rr) do { const int r_ = (rr), i_ = r_ - r_begin; \
        const unsigned s0_ = (unsigned)__builtin_amdgcn_readlane((int)myslot.x, i_), s1_ = (unsigned)__builtin_amdgcn_readlane((int)myslot.y, i_); \
        const unsigned char* p0_ = YS + (size_t)s0_ * D; const unsigned char* p1_ = YS + (size_t)s1_ * D; \
        _Pragma("unroll") for (int j = 0; j < 4; ++j) { p##S.w[j] = *(const unsigned*)(p0_ + 256 * j + 4 * lane); q##S.w[j] = *(const unsigned*)(p1_ + 256 * j + 4 * lane); } \
        ldraw_bf16(x##S, XR(r_), lane); } while (0)
#define FN_PROC(S, rr) do { const int r_ = (rr), i_ = r_ - r_begin; \
        const float w0 = __builtin_bit_cast(float, __builtin_amdgcn_readlane((int)mywt.x, i_)), w1 = __builtin_bit_cast(float, __builtin_amdgcn_readlane((int)mywt.y, i_)); \
        typedef float f32x2_ __attribute__((ext_vector_type(2))); \
        Row y; Row x = cvt_row(x##S); \
        _Pragma("unroll") for (int j = 0; j < 4; ++j) { \
            const f32x2_ a0 = __builtin_amdgcn_cvt_pk_f32_fp8((int)p##S.w[j], false), a1 = __builtin_amdgcn_cvt_pk_f32_fp8((int)p##S.w[j], true); \
            const f32x2_ b0 = __builtin_amdgcn_cvt_pk_f32_fp8((int)q##S.w[j], false), b1 = __builtin_amdgcn_cvt_pk_f32_fp8((int)q##S.w[j], true); \
            y.v[j] = (f32x4){a0.x * w0 + b0.x * w1, a0.y * w0 + b0.y * w1, a1.x * w0 + b1.x * w1, a1.y * w0 + b1.y * w1}; } \
        const float rs = row_rstd(y); \
        _Pragma("unroll") for (int j = 0; j < 4; ++j) x.v[j] = x.v[j] + gg.v[j] * (y.v[j] * rs); \
        st_row_f32(AOUT + (size_t)r_ * D, lane, x); \
    } while (0)
    ROW_SEGMENTS({ const Row gg = row_mul(ld_row_f32(modp(MOD, 1, bb, 5), lane), g); ROWS3(FN_LOAD, FN_PROC, rb, re); });
    }
#undef FN_LOAD
#undef FN_PROC
}
#undef SRC0
__device__ __forceinline__ void expert_offsets(const unsigned* ecnt, unsigned (&off)[9]) {
    off[0] = 0u;
#pragma unroll
    for (int e = 0; e < 8; ++e) off[e + 1] = off[e] + ((ecnt[e] + 255u) & ~255u);
}
__device__ __forceinline__ void phase_gather(const CAS DArgs& a) {
    const int tid = fresh_tid(), lane = tid & 63, wave = __builtin_amdgcn_readfirstlane(tid >> 6); const int G = gridDim.x, wg = blockIdx.x;
    const int gw = wg * NWAVES + wave, NGW = G * NWAVES;
    unsigned char* tk = AWS + WS_TOK; const unsigned* ecnt = (const unsigned*)(AWS + WS_CTL) + CW_ECNT;
    unsigned cnt[8], off[9];
#pragma unroll
    for (int e = 0; e < 8; ++e) cnt[e] = __hip_atomic_load(ecnt + e, __ATOMIC_RELAXED, __HIP_MEMORY_SCOPE_AGENT);
    expert_offsets(cnt, off);
    const unsigned char* H = AWS + WS_H; unsigned char* GA = AWS + WS_GATH;
    for (int rbase = gw; rbase < ML; rbase += NGW * 64) {
        const int nrw = (ML - rbase + NGW - 1) / NGW < 64 ? (ML - rbase + NGW - 1) / NGW : 64;
        unsigned s0 = 0u, s1 = 0u;
        if (lane < nrw) { const int r = rbase + lane * NGW;
            const int owner = row_owner_wg(r, ML, NGW);
            const unsigned ee = ((const unsigned*)(tk + TOK_E))[r]; const int e0 = ee & 255, e1 = (ee >> 8) & 255;
            const unsigned* wb = (const unsigned*)(tk + TOK_WGBASE) + owner * 8;
            unsigned o0 = 0, o1 = 0;
#pragma unroll
            for (int e = 0; e < 8; ++e) { o0 = (e == e0) ? off[e] : o0; o1 = (e == e1) ? off[e] : o1; }
            s0 = o0 + wb[e0] + ((const unsigned*)(tk + TOK_RANK))[2 * r]; s1 = o1 + wb[e1] + ((const unsigned*)(tk + TOK_RANK))[2 * r + 1];
            *(u32x2*)((unsigned*)(tk + TOK_SLOT) + 2 * r) = (u32x2){s0, s1}; }
        for (int i0 = 0; i0 < nrw; i0 += 8) {
            u32x4 v[8];
#pragma unroll
            for (int q = 0; q < 8; ++q) { const int i = (i0 + q < nrw) ? i0 + q : nrw - 1; v[q] = ((const u32x4*)(H + (size_t)(rbase + i * NGW) * D))[lane]; }
#pragma unroll
            for (int q = 0; q < 8; ++q) { if (i0 + q < nrw) { const unsigned a0 = (unsigned)__builtin_amdgcn_readlane((int)s0, i0 + q), a1 = (unsigned)__builtin_amdgcn_readlane((int)s1, i0 + q);
                ((u32x4*)(GA + (size_t)a0 * D))[lane] = v[q]; ((u32x4*)(GA + (size_t)a1 * D))[lane] = v[q]; } }
        }
    }
    for (int e = 0; e < 8; ++e) { const unsigned p0 = off[e] + cnt[e], p1 = off[e + 1];
        for (unsigned s = p0 + gw; s < p1; s += NGW) ((u32x4*)(GA + (size_t)s * D))[lane] = (u32x4){0u, 0u, 0u, 0u}; }
    if (wg == 0) { int* texp = (int*)(tk + TOK_TEXP);
        for (int t = tid; t < MAXTILE; t += NTHR) { int e = 0;
#pragma unroll
            for (int q = 1; q < 8; ++q) e = ((unsigned)(t * 256) >= off[q]) ? q : e;
            texp[t] = e; } }
}

constexpr int G1P = 72;
constexpr int G1_QT = 0, G1_KT = 18432, G1_KH = 36864, G1_VT = 55296, G1_AT = 73728, G1_WD = 82944, G1_BD = 91136;
template <int CTRL, int RM> __device__ __forceinline__ float dppf(float v) { return __builtin_bit_cast(float, __builtin_amdgcn_update_dpp(0, __builtin_bit_cast(int, v), CTRL, RM, 0xf, true)); }
__device__ __forceinline__ float wave_incl_scan(float v) {
    v += dppf<0x111, 0xf>(v); v += dppf<0x112, 0xf>(v); v += dppf<0x114, 0xf>(v); v += dppf<0x118, 0xf>(v);
    v += dppf<0x142, 0xa>(v); v += dppf<0x143, 0xc>(v); return v; }
__device__ __forceinline__ size_t us_slot(int chunk, int h, int dir) { return ((size_t)(chunk * 4 + h) * 2 + dir) * 8192; }
__device__ __forceinline__ float log_sigmoid(float z) { return fminf(z, 0.f) - __logf(1.0f + __expf(-fabsf(z))); }

__device__ __forceinline__ void phase_gla_local(const CAS DArgs& a, int l, LAS unsigned char* lds) {
    const int tid = fresh_tid(), lane = tid & 63, wave = __builtin_amdgcn_readfirstlane(tid >> 6); const int G = gridDim.x, wg = blockIdx.x;
    bf16* P = (bf16*)(AWS + WS_P); unsigned char* U8 = AWS + WS_U8; float* DC = (float*)(AWS + WS_DC);
    LAS bf16* QT = (LAS bf16*)(lds + G1_QT); LAS bf16* KT = (LAS bf16*)(lds + G1_KT); LAS bf16* KH = (LAS bf16*)(lds + G1_KH);
    LAS bf16* VT = (LAS bf16*)(lds + G1_VT); LAS bf16* AT = (LAS bf16*)(lds + G1_AT);
    LAS float* WD = (LAS float*)(lds + G1_WD); LAS float* BD = (LAS float*)(lds + G1_BD);
    const int fr = lane & 15, fq = lane >> 4;
    const int dir = wave >> 2, d0 = (wave & 3) * 16;
    u32x4 pa0, pa1, pq0, pq1, pk0, pk1, pv0, pv1;
#define G1_LOAD_AQK(uu) do { const int ch_ = (uu) >> 2, hh_ = (uu) & 3; const bf16* pr_ = P + (size_t)(ch_ * 64 + lane) * LDP; \
        pa0 = *(const u32x4*)(pr_ + PA + 16 * dir); pa1 = *(const u32x4*)(pr_ + PA + 16 * dir + 8); \
        pq0 = *(const u32x4*)(pr_ + PQ + 64 * hh_ + d0); pq1 = *(const u32x4*)(pr_ + PQ + 64 * hh_ + d0 + 8); \
        pk0 = *(const u32x4*)(pr_ + PK + 64 * hh_ + d0); pk1 = *(const u32x4*)(pr_ + PK + 64 * hh_ + d0 + 8); } while (0)
#define G1_LOAD_V(uu) do { const int ch_ = (uu) >> 2, hh_ = (uu) & 3; \
        const bf16* vr_ = P + (size_t)(ch_ * 64 + (tid >> 3)) * LDP + PV + 128 * hh_ + (tid & 7) * 16; pv0 = *(const u32x4*)vr_; pv1 = *(const u32x4*)(vr_ + 8); } while (0)
#define G1_LOAD(uu) do { G1_LOAD_AQK(uu); G1_LOAD_V(uu); } while (0)
    if (wg < NCHUNK * 4) G1_LOAD(wg);
    int hcur = -1;
    for (int u = wg; u < NCHUNK * 4; u += G) {
        const int chunk = u >> 2, h = u & 3;
        if (h != hcur) { hcur = h; const int dr = tid >> 8, d = (tid >> 2) & 63, r0 = (tid & 3) * 4;
          const float* wsrc = AIN(9) + ((size_t)(l * 2 + dr) * 16 + r0) * 256 + 64 * h + d;
          *(LAS f32x4*)(WD + (dr * 64 + d) * 16 + r0) = (f32x4){wsrc[0], wsrc[256], wsrc[512], wsrc[768]};
          if (tid < 128) BD[tid] = AIN(10)[(size_t)(l * 2 + (tid >> 6)) * 256 + 64 * h + (tid & 63)];
          __syncthreads(); }
        {
            bf16* prow = P + (size_t)(chunk * 64 + lane) * LDP;
            float av[16], qv[16], kv[16];
#pragma unroll
            for (int i = 0; i < 4; ++i) { av[2 * i] = bflo(pa0[i]); av[2 * i + 1] = bfhi(pa0[i]); av[8 + 2 * i] = bflo(pa1[i]); av[9 + 2 * i] = bfhi(pa1[i]);
                qv[2 * i] = bflo(pq0[i]); qv[2 * i + 1] = bfhi(pq0[i]); qv[8 + 2 * i] = bflo(pq1[i]); qv[9 + 2 * i] = bfhi(pq1[i]);
                kv[2 * i] = bflo(pk0[i]); kv[2 * i + 1] = bfhi(pk0[i]); kv[8 + 2 * i] = bflo(pk1[i]); kv[9 + 2 * i] = bfhi(pk1[i]); }
            if (u + G < NCHUNK * 4) G1_LOAD_AQK(u + G);
            unsigned qpk[8], kpk[8];
            float dtot = 0.f, qt_e = 0.f, kt_e = 0.f, kh_e = 0.f;
#pragma unroll
            for (int g4 = 0; g4 < 4; ++g4) {
                float la4[4], inc4[4];
#pragma unroll
                for (int q = 0; q < 4; ++q) { const int dd = 4 * g4 + q;
                    const LAS f32x4* wv = (const LAS f32x4*)(WD + (dir * 64 + d0 + dd) * 16);
                    const f32x4 w0 = wv[0], w1 = wv[1], w2 = wv[2], w3 = wv[3];
                    float z = BD[dir * 64 + d0 + dd];
#pragma unroll
                    for (int r = 0; r < 4; ++r) z += av[r] * w0[r] + av[4 + r] * w1[r] + av[8 + r] * w2[r] + av[12 + r] * w3[r];
                    la4[q] = (fminf(z, 0.f) * 1.44269504f - __builtin_amdgcn_logf(1.0f + __builtin_amdgcn_exp2f(-1.44269504f * fabsf(z)))) * (1.0f / 16.0f);
                    inc4[q] = la4[q]; }
#define G1_SCAN_STEP(CTRL, RM) _Pragma("unroll") for (int q = 0; q < 4; ++q) inc4[q] += dppf<CTRL, RM>(inc4[q]);
                G1_SCAN_STEP(0x111, 0xf) G1_SCAN_STEP(0x112, 0xf) G1_SCAN_STEP(0x114, 0xf) G1_SCAN_STEP(0x118, 0xf) G1_SCAN_STEP(0x142, 0xa) G1_SCAN_STEP(0x143, 0xc)
#undef G1_SCAN_STEP
#pragma unroll
                for (int q = 0; q < 4; ++q) { const int dd = 4 * g4 + q; const float la = la4[q], inc = inc4[q];
                    const float tot = __builtin_bit_cast(float, __builtin_amdgcn_readlane(__builtin_bit_cast(int, inc), 63));
                    const float bc = dir == 0 ? inc : (tot - inc + la);
                    const float etot = __builtin_amdgcn_exp2f(tot);
                    const float qt = qv[dd] * 0.125f * __builtin_amdgcn_exp2f(bc), kt = kv[dd] * __builtin_amdgcn_exp2f(-bc), kh = kt * etot;
                    if (dd & 1) { qpk[dd >> 1] = pk2(qt_e, qt); kpk[dd >> 1] = pk2(kt_e, kt); const unsigned khp = pk2(kh_e, kh);
                        KH[(dir * 64 + d0 + dd - 1) * G1P + lane] = (bf16)(khp & 0xffffu); KH[(dir * 64 + d0 + dd) * G1P + lane] = (bf16)(khp >> 16); }
                    else { qt_e = qt; kt_e = kt; kh_e = kh; }
                    dtot = (lane == dd) ? etot : dtot; }
            }
            *(LAS u32x4*)(QT + (dir * 64 + lane) * G1P + d0) = (u32x4){qpk[0], qpk[1], qpk[2], qpk[3]}; *(LAS u32x4*)(QT + (dir * 64 + lane) * G1P + d0 + 8) = (u32x4){qpk[4], qpk[5], qpk[6], qpk[7]};
            *(LAS u32x4*)(KT + (dir * 64 + lane) * G1P + d0) = (u32x4){kpk[0], kpk[1], kpk[2], kpk[3]}; *(LAS u32x4*)(KT + (dir * 64 + lane) * G1P + d0 + 8) = (u32x4){kpk[4], kpk[5], kpk[6], kpk[7]};
            if (lane < 16) DC[((size_t)(chunk * 4 + h) * 2 + dir) * 64 + d0 + lane] = dtot;
            { const int j = tid >> 3, eb = (tid & 7) * 16;
              const int js = (((j >> 3) ^ (tid & 7)) << 3) | (j & 7);
#pragma unroll
              for (int i = 0; i < 4; ++i) { VT[(eb + 2 * i) * G1P + js] = (bf16)(pv0[i] & 0xffffu); VT[(eb + 2 * i + 1) * G1P + js] = (bf16)(pv0[i] >> 16);
                  VT[(eb + 8 + 2 * i) * G1P + js] = (bf16)(pv1[i] & 0xffffu); VT[(eb + 9 + 2 * i) * G1P + js] = (bf16)(pv1[i] >> 16); } }
            LDS_BARRIER();
            if (u + G < NCHUNK * 4) G1_LOAD_V(u + G);
            bf16* qd = prow + (dir == 0 ? PQ : PK) + 64 * h + d0;
            *(u32x4*)qd = (u32x4){qpk[0], qpk[1], qpk[2], qpk[3]}; *(u32x4*)(qd + 8) = (u32x4){qpk[4], qpk[5], qpk[6], qpk[7]};
        }
#pragma unroll
        for (int t = 0; t < 2; ++t) {
            const int job = wave * 2 + t, jt = job >> 2, it = job & 3;
            f32x4 accf = (f32x4){0.f, 0.f, 0.f, 0.f}, accb = (f32x4){0.f, 0.f, 0.f, 0.f};
#pragma unroll
            for (int ks = 0; ks < 2; ++ks) {
                const bf16x8 ka = *(const LAS bf16x8*)(KT + (0 * 64 + 16 * jt + fr) * G1P + 32 * ks + 8 * fq), qa = *(const LAS bf16x8*)(QT + (0 * 64 + 16 * it + fr) * G1P + 32 * ks + 8 * fq);
                accf = __builtin_amdgcn_mfma_f32_16x16x32_bf16(ka, qa, accf, 0, 0, 0);
                const bf16x8 kb = *(const LAS bf16x8*)(KT + (1 * 64 + 16 * jt + fr) * G1P + 32 * ks + 8 * fq), qb = *(const LAS bf16x8*)(QT + (1 * 64 + 16 * it + fr) * G1P + 32 * ks + 8 * fq);
                accb = __builtin_amdgcn_mfma_f32_16x16x32_bf16(kb, qb, accb, 0, 0, 0);
            }
            const int i = 16 * it + fr, j0 = 16 * jt + 4 * fq;
            float s[4];
#pragma unroll
            for (int r = 0; r < 4; ++r) { const int j = j0 + r; s[r] = (j <= i ? accf[r] : 0.f) + (j >= i ? accb[r] : 0.f); }
            u32x2 w; w.x = pk2(s[0], s[1]); w.y = pk2(s[2], s[3]);
            *(LAS u32x2*)(AT + i * G1P + j0) = w;
        }
        LDS_BARRIER();
        {
            const int ew = wave & 3, ih = wave >> 2;
            bf16x8 vo[2][2];
#pragma unroll
            for (int j = 0; j < 2; ++j)
#pragma unroll
                for (int ks = 0; ks < 2; ++ks) vo[j][ks] = *(const LAS bf16x8*)(VT + (32 * ew + 8 * (fr >> 2) + 4 * j + (fr & 3)) * G1P + 8 * ((4 * ks + fq) ^ (2 * ew + (fr >> 3))));
#pragma unroll
            for (int t = 0; t < 2; ++t) { const int it = 2 * ih + t;
                f32x4 acc0 = (f32x4){0.f, 0.f, 0.f, 0.f}, acc1 = (f32x4){0.f, 0.f, 0.f, 0.f};
#pragma unroll
                for (int ks = 0; ks < 2; ++ks) { const bf16x8 af = *(const LAS bf16x8*)(AT + (16 * it + fr) * G1P + 32 * ks + 8 * fq);
                    acc0 = __builtin_amdgcn_mfma_f32_16x16x32_bf16(vo[0][ks], af, acc0, 0, 0, 0); acc1 = __builtin_amdgcn_mfma_f32_16x16x32_bf16(vo[1][ks], af, acc1, 0, 0, 0); }
                u32x4 w; w.x = pk2_sw(acc0[0], acc0[1]); w.y = pk2_sw(acc0[2], acc0[3]); w.z = pk2_sw(acc1[0], acc1[1]); w.w = pk2_sw(acc1[2], acc1[3]);
                *(u32x4*)(P + (size_t)(chunk * 64 + 16 * it + fr) * LDP + PV + 128 * h + 32 * ew + 8 * fq) = w;
            }
            const int et = wave;
            bf16x8 vf[2];
#pragma unroll
            for (int ks = 0; ks < 2; ++ks) vf[ks] = *(const LAS bf16x8*)(VT + (16 * et + fr) * G1P + 8 * ((4 * ks + fq) ^ et));
#pragma unroll
            for (int dr = 0; dr < 2; ++dr) {
                u32x4 wq;
#pragma unroll
                for (int dt = 0; dt < 4; ++dt) {
                    f32x4 acc = (f32x4){0.f, 0.f, 0.f, 0.f};
#pragma unroll
                    for (int ks = 0; ks < 2; ++ks) { const bf16x8 kf = *(const LAS bf16x8*)(KH + (dr * 64 + 16 * (fr >> 2) + 4 * dt + (fr & 3)) * G1P + 32 * ks + 8 * fq);
                        acc = __builtin_amdgcn_mfma_f32_16x16x32_bf16(kf, vf[ks], acc, 0, 0, 0); }
                    wq[dt] = pk4_fp8(acc[0], acc[1], acc[2], acc[3]);
                }
                *(u32x4*)(U8 + us_slot(chunk, h, dr) + (size_t)(16 * et + fr) * 64 + 16 * fq) = wq;
            }
        }
        LDS_BARRIER();
    }
}
#undef G1_LOAD
#undef G1_LOAD_AQK
#undef G1_LOAD_V
__device__ __forceinline__ void phase_conv(const CAS DArgs& a, int l) {
    const int tid = fresh_tid(); const int G = gridDim.x, wg = blockIdx.x;
    const bf16* P = (const bf16*)(AWS + WS_P); bf16* MIX = (bf16*)(AWS + WS_H);
    const float* cw = AIN(12) + (size_t)l * 3 * 512;
    const int nrows = l == 0 ? MT : ML;
    const int c8 = (tid & 63) * 8;
    float wl[3][8];
#pragma unroll
    for (int k = 0; k < 3; ++k) { const f32x4 wa = *(const f32x4*)(cw + 512 * k + c8), wb = *(const f32x4*)(cw + 512 * k + c8 + 4);
#pragma unroll
        for (int i = 0; i < 4; ++i) { wl[k][i] = wa[i]; wl[k][4 + i] = wb[i]; } }
    const int ngroups = nrows / 4;
    for (int g = wg * 8 + (tid >> 6); g < ngroups; g += G * 8) {
        const int r0 = g * 4;
        const int t0 = r0 < ML ? (r0 & 63) : ((r0 - ML) & 255); const int last = r0 < ML ? 63 : 255;
        const bf16* pr = P + (size_t)r0 * LDP;
        u32x4 u[6], bg[4];
        u[0] = (u32x4){0u, 0u, 0u, 0u}; u[5] = (u32x4){0u, 0u, 0u, 0u};
        if (t0 > 0) u[0] = *(const u32x4*)(pr - LDP + PU + c8);
#pragma unroll
        for (int i = 0; i < 4; ++i) { u[1 + i] = *(const u32x4*)(pr + (size_t)i * LDP + PU + c8); bg[i] = *(const u32x4*)(pr + (size_t)i * LDP + PB + c8); }
        if (t0 + 3 < last) u[5] = *(const u32x4*)(pr + (size_t)4 * LDP + PU + c8);
#pragma unroll
        for (int i = 0; i < 4; ++i) {
            float o[8];
#pragma unroll
            for (int q = 0; q < 4; ++q) {
                o[2 * q] = bflo(bg[i][q]) * (wl[0][2 * q] * bflo(u[i][q]) + wl[1][2 * q] * bflo(u[i + 1][q]) + wl[2][2 * q] * bflo(u[i + 2][q]));
                o[2 * q + 1] = bfhi(bg[i][q]) * (wl[0][2 * q + 1] * bfhi(u[i][q]) + wl[1][2 * q + 1] * bfhi(u[i + 1][q]) + wl[2][2 * q + 1] * bfhi(u[i + 2][q]));
            }
            *(u32x4*)(MIX + (size_t)(r0 + i) * D + 512 + c8) = (u32x4){pk2(o[0], o[1]), pk2(o[2], o[3]), pk2(o[4], o[5]), pk2(o[6], o[7])};
        }
    }
}
__device__ __forceinline__ void phase_gla_scan(const CAS DArgs& a) {
    const int tid = fresh_tid(); const int G = gridDim.x, wg = blockIdx.x;
    bf16* US = (bf16*)(AWS + WS_US); const unsigned char* U8 = AWS + WS_U8; const float* DC = (const float*)(AWS + WS_DC);
    for (int w = wg; w < NB * 4 * 2 * 2; w += G) {
        const int prob = w >> 1, g8 = (w & 1) * 512 + tid, dir = prob & 1, h = (prob >> 1) & 3, b = prob >> 3;
        const int dg = (g8 & 7) * 8;
#define SCAN_CHUNK(s) (((s) < 4) ? (ML / 64 + b * 4 + (dir == 0 ? (s) : 3 - (s))) : (b * 64 + (dir == 0 ? (s) - 4 : 67 - (s))))
        float S[8];
#pragma unroll
        for (int i = 0; i < 8; ++i) { S[i] = 0.f; asm volatile("" : "+v"(S[i])); }
        u32x2 uw[4]; f32x4 da[4], db[4];
#define SCAN_LOAD(k, s) do { const int c_ = SCAN_CHUNK(s); uw[k] = *(const u32x2*)(U8 + us_slot(c_, h, dir) + (size_t)g8 * 8); \
            const float* dc = DC + ((size_t)(c_ * 4 + h) * 2 + dir) * 64 + dg; da[k] = *(const f32x4*)dc; db[k] = *(const f32x4*)(dc + 4); } while (0)
#pragma unroll
        for (int k = 0; k < 4; ++k) SCAN_LOAD(k, k);
        for (int s0 = 0; s0 < 68; s0 += 4) {
#pragma unroll
            for (int k = 0; k < 4; ++k) {
                const int s = s0 + k; const int chunk = SCAN_CHUNK(s);
                typedef float f32x2_ __attribute__((ext_vector_type(2)));
                const u32x2 u = uw[k]; const f32x4 d0 = da[k], d1 = db[k];
                *(u32x4*)(US + us_slot(chunk, h, dir) + (size_t)g8 * 8) = (u32x4){pk2(S[0], S[1]), pk2(S[2], S[3]), pk2(S[4], S[5]), pk2(S[6], S[7])};
                const f32x2_ u01 = __builtin_amdgcn_cvt_pk_f32_fp8((int)u.x, false), u23 = __builtin_amdgcn_cvt_pk_f32_fp8((int)u.x, true), u45 = __builtin_amdgcn_cvt_pk_f32_fp8((int)u.y, false), u67 = __builtin_amdgcn_cvt_pk_f32_fp8((int)u.y, true);
                S[0] = d0[0] * S[0] + u01.x; S[1] = d0[1] * S[1] + u01.y; S[2] = d0[2] * S[2] + u23.x; S[3] = d0[3] * S[3] + u23.y;
                S[4] = d1[0] * S[4] + u45.x; S[5] = d1[1] * S[5] + u45.y; S[6] = d1[2] * S[6] + u67.x; S[7] = d1[3] * S[7] + u67.y;
                SCAN_LOAD(k, (s + 4 < 68 ? s + 4 : 67));
            }
        }
#undef SCAN_LOAD
#undef SCAN_CHUNK
    }
}
constexpr int G3_GN = 131072 + 2048;
__device__ __forceinline__ void phase_gla_out(const CAS DArgs& a, int l, LAS unsigned char* lds) {
    const int tid = fresh_tid(), lane = tid & 63, wave = __builtin_amdgcn_readfirstlane(tid >> 6); const int G = gridDim.x, wg = blockIdx.x;
    const bf16* P = (const bf16*)(AWS + WS_P); const unsigned char* USb = (const unsigned char*)(AWS + WS_US); bf16* MIX = (bf16*)(AWS + WS_H);
    const int fr = lane & 15, fq = lane >> 4, it = wave & 3, grp = wave >> 2;
    const int nunits = (l == 0 ? NCHUNK : ML / 64) * 4;
    if (tid < 128) *(LAS float*)(lds + G3_GN + 4 * tid) = (AIN(11) + (size_t)l * 128)[tid];
    unsigned srcoff[4];
#pragma unroll
    for (int i = 0; i < 4; ++i) { const int p = (4 * it + i) * 64 + lane, r = p >> 3, c = (p & 7) ^ ((r >> 1) & 7); srcoff[i] = (unsigned)(r * 128 + c * 16); }
    const int fo0 = fr * 128 + (((0 + fq) ^ (fr >> 1)) * 16), fo1 = fr * 128 + (((4 + fq) ^ (fr >> 1)) * 16);
    bf16x8 qfA[2][2], qfB[2][2]; u32x2 oiA[8], ggA[8], oiB[8], ggB[8];
#define G3_FETCH(uu, buf, QF, OI, GG) do { const int ch_ = (uu) >> 2, hh_ = (uu) & 3; \
        _Pragma("unroll") for (int dr = 0; dr < 2; ++dr) _Pragma("unroll") for (int i = 0; i < 4; ++i) \
            __builtin_amdgcn_global_load_lds((const unsigned*)(USb + us_slot(ch_, hh_, dr) * 2 + srcoff[i]), (LAS unsigned*)(lds + ((((buf) * 2 + grp) * 2 + dr) * 16384) + (4 * it + i) * 1024), 16, 0, 0); \
        const bf16* pr_ = P + (size_t)(ch_ * 64 + 16 * it + fr) * LDP; \
        _Pragma("unroll") for (int dr = 0; dr < 2; ++dr) _Pragma("unroll") for (int ks = 0; ks < 2; ++ks) QF[dr][ks] = *(const bf16x8*)(pr_ + (dr == 0 ? PQ : PK) + 64 * hh_ + 32 * ks + 8 * fq); \
        _Pragma("unroll") for (int et = 0; et < 8; ++et) { OI[et] = *(const u32x2*)(pr_ + PV + 128 * hh_ + 16 * et + 4 * fq); GG[et] = *(const u32x2*)(pr_ + PGT + 128 * hh_ + 16 * et + 4 * fq); } } while (0)
#define G3_UNIT(buf, QF, OI, GG, QFN, OIN, GGN) { \
        __builtin_amdgcn_s_waitcnt(0x0F78);                    \
        LDS_BARRIER();                                        \
        const int un = u + G * 2; const bool hn = un < nunits; \
        G3_FETCH((hn ? un : u), 1 - (buf), QFN, OIN, GGN);      \
        const int chunk = u >> 2, h = u & 3; \
        const int row = chunk * 64 + 16 * it + fr; \
        LAS const unsigned char* img = lds + ((buf) * 2 + grp) * 2 * 16384; \
        f32x4 acc[8]; float ss = 0.f; \
        _Pragma("unroll") for (int et = 0; et < 8; ++et) { \
            acc[et] = (f32x4){0.f, 0.f, 0.f, 0.f}; \
            _Pragma("unroll") for (int dr = 0; dr < 2; ++dr) { \
                const bf16x8 s0 = *(const LAS bf16x8*)(img + dr * 16384 + et * 2048 + fo0), s1 = *(const LAS bf16x8*)(img + dr * 16384 + et * 2048 + fo1); \
                acc[et] = __builtin_amdgcn_mfma_f32_16x16x32_bf16(s0, QF[dr][0], acc[et], 0, 0, 0); \
                acc[et] = __builtin_amdgcn_mfma_f32_16x16x32_bf16(s1, QF[dr][1], acc[et], 0, 0, 0); \
            } \
              \
            acc[et][0] += bflo(OI[et].x); acc[et][1] += bfhi(OI[et].x); acc[et][2] += bflo(OI[et].y); acc[et][3] += bfhi(OI[et].y); \
            ss += (acc[et][0] * acc[et][0] + acc[et][1] * acc[et][1]) + (acc[et][2] * acc[et][2] + acc[et][3] * acc[et][3]); \
        } \
        ss += __shfl_xor(ss, 16); ss += __shfl_xor(ss, 32); \
        const float rs = __builtin_amdgcn_rsqf(ss * (1.0f / 128.0f) + EPS); \
        _Pragma("unroll") for (int et = 0; et < 8; ++et) { \
            const int e = 16 * et + 4 * fq; \
            const f32x4 gv = *(const LAS f32x4*)(lds + G3_GN + 4 * e); \
            const float g0 = bflo(GG[et].x), g1 = bfhi(GG[et].x), g2 = bflo(GG[et].y), g3 = bfhi(GG[et].y); \
            const float o0 = acc[et][0] * rs * gv[0] * pg8::silu_f(g0), o1 = acc[et][1] * rs * gv[1] * pg8::silu_f(g1), o2 = acc[et][2] * rs * gv[2] * pg8::silu_f(g2), o3 = acc[et][3] * rs * gv[3] * pg8::silu_f(g3); \
            u32x2 w; w.x = pk2(o0, o1); w.y = pk2(o2, o3); \
            *(u32x2*)(MIX + (size_t)row * D + 128 * h + e) = w; \
        } \
        u = un; if (!hn) break; }
    int u = wg * 2 + grp;
    if (u < nunits) {
        G3_FETCH(u, 0, qfA, oiA, ggA);
        __builtin_amdgcn_s_waitcnt(0x0F70);
        for (;;) {
            G3_UNIT(0, qfA, oiA, ggA, qfB, oiB, ggB)
            G3_UNIT(1, qfB, oiB, ggB, qfA, oiA, ggA)
        }
    }
#undef G3_UNIT
#undef G3_FETCH
}

constexpr int NPHASE = 29;
__global__ void __launch_bounds__(NTHR, 2) mk_fwd(Args args) {
    extern __shared__ __attribute__((aligned(16))) unsigned char lds_raw[];
    LAS unsigned char* lds = (LAS unsigned char*)lds_raw;
    const int tid = threadIdx.x, lane = tid & 63, wave = __builtin_amdgcn_readfirstlane(tid >> 6);
    const int G = gridDim.x, wg = blockIdx.x;
    const int vcu = (G % 8 == 0) ? (wg % 8) * (G / 8) + wg / 8 : wg;
    const int gw = vcu * NWAVES + wave, NGW = G * NWAVES;
    const CAS DArgs* kap = (const CAS DArgs*)__builtin_amdgcn_kernarg_segment_ptr();
#define KA() (*({ const CAS DArgs* _p = kap; asm volatile("" : "+s"(_p)); _p; }))
    unsigned char* ws = args.ws;
    for (int u = tid; u < (LDS_BYTES - LDSCTL_OFF) / 4; u += NTHR) ((LAS unsigned*)(lds + LDSCTL_OFF))[u] = 0u;
    __syncthreads();
    XcdBarrier bar; bar.bar = (unsigned*)(ws + WS_CTL) + CW_BAR; bar.x = 0; bar.st = nullptr;
#if !MK_PER_PHASE
    bar = xcd_barrier_post((unsigned*)(ws + WS_CTL) + CW_BAR, (volatile LAS unsigned*)(lds + LDSCTL_OFF));
#endif
    const int lo = args.ph_lo, hi = args.ph_hi;
    unsigned long long probe_t0 = PROBE_MASK != 0u ? __builtin_amdgcn_s_memrealtime() : 0ull; (void)probe_t0;
#define IN(k) (lo <= (k) && (k) < hi)
#if MK_PER_PHASE
#define SEAM(k) do { } while (0)
#else
#define SEAM(k) do { if (PROBE_MASK != 0u) { if ((PROBE_MASK >> (k)) & 1u) { const unsigned long long t1_ = __builtin_amdgcn_s_memrealtime(); const unsigned long long te_ = t1_ + (t1_ - probe_t0); \
        while (__builtin_amdgcn_s_memrealtime() < te_) __builtin_amdgcn_s_sleep(8); } } \
    if (IN(k) && IN((k) + 1)) { XcdBarrier b2_ = bar; asm volatile("" : "+s"(b2_.bar)); xcd_barrier(b2_); } if (PROBE_MASK != 0u) probe_t0 = __builtin_amdgcn_s_memrealtime(); } while (0)
#endif
#define WSP ((unsigned char*)KA().ws)
#define Hb ((bf16*)(WSP + WS_H))
#define Pb ((bf16*)(WSP + WS_P))

    if (IN(0)) { p0_prologue(KA(), lds); } SEAM(0);
    if (IN(1)) { quantize_weights(KA(), lds); phase_normmod0(KA()); } SEAM(1);

    for (int l = 0; l < 2; ++l) {
        const int pb = 9 * l;
        if (IN(2 + pb)) {
            pg8::Gemm g{l == 0 ? WSP + WS_H : WSP + WS_US, WSP + WS_WIN + (size_t)l * NPROJ * D, MT, NPROJ, D}; pg8::StaticOrder S; S.init(MT, NPROJ, G, wg);
            pg8::EpiInProjI8 E{Pb, LDP, pg8::LdsScales{(const float*)(WSP + WS_SA), (const float*)(WSP + WS_SBIN) + l * NPROJ, lds}};
            pg8::gemm_phase<pg8::EpiInProjI8, pg8::StaticOrder, 2>(lds, g, S, E);
        } SEAM(2 + pb);
        if (IN(3 + pb)) { phase_gla_local(KA(), l, lds); phase_conv(KA(), l); } SEAM(3 + pb);
        if (IN(4 + pb)) { phase_gla_scan(KA()); } SEAM(4 + pb);
        if (IN(5 + pb)) { phase_gla_out(KA(), l, lds); } SEAM(5 + pb);
        if (IN(6 + pb)) {
            const int M = l == 0 ? MT : ML;
            pg8::Gemm g{Hb, (const bf16*)(WSP + WS_WOUT) + (size_t)l * D * D, M, D, D}; pg8::StaticOrder S; S.init(M, D, G, wg);
            pg8::EpiPlain E{Pb, D};
            pg8::gemm_phase<pg8::EpiPlain, pg8::StaticOrder>(lds, g, S, E);
            if (l == 0) {
                const int nwgu = (MT / 256) * (D / 256), nfull = nwgu % G;
                __syncthreads();
                if (nfull == 0) convert_expert_weights(KA(), lds, wg * NWAVES + wave, G * NWAVES, 1);
                else if (wg >= nfull) convert_expert_weights(KA(), lds, (wg - nfull) * NWAVES + wave, (G - nfull) * NWAVES, 1); }
        } SEAM(6 + pb);
        if (IN(7 + pb)) { if (l == 0) phase_postmix<0>(KA(), lds); else phase_postmix<1>(KA(), lds); } SEAM(7 + pb);
        if (l == 0) {
            if (IN(8)) {
                pg8::Gemm g{Hb, WSP + WS_W13, MT, 2 * DFF, D}; pg8::StaticOrder S; S.init(MT, 2 * DFF, G, wg);
                pg8::EpiPairI8<1> E{Pb, DFF, pg8::LdsScales{(const float*)(WSP + WS_SA), (const float*)(WSP + WS_SB13), lds}};
                pg8::gemm_phase<pg8::EpiPairI8<1>, pg8::StaticOrder, 2>(lds, g, S, E);
            } SEAM(8);
            if (IN(9)) {
                pg8::Gemm g{Pb, WSP + WS_W2, MT, D, DFF}; pg8::StaticOrder S; S.init(MT, D, G, wg);
                pg8::EpiPlain E{Hb, D, 1.0f / W2_SCALE};
                pg8::gemm_phase<pg8::EpiPlain, pg8::StaticOrder, 1>(lds, g, S, E);
                { const int nwgu = (MT / 256) * (D / 256), nfull = nwgu % G;
                  __syncthreads();
                  if (nfull == 0) convert_expert_weights(KA(), lds, wg * NWAVES + wave, G * NWAVES, 0);
                  else if (wg >= nfull) convert_expert_weights(KA(), lds, (wg - nfull) * NWAVES + wave, (G - nfull) * NWAVES, 0); }
            } SEAM(9);
            if (IN(10)) { phase_postffn0(KA()); } SEAM(10);
        }
    }
    if (IN(17)) { phase_gather(KA()); } SEAM(17);
    {
        unsigned cnt[8], off[9];
        const unsigned* ecnt = (const unsigned*)(WSP + WS_CTL) + CW_ECNT;
        if (hi > 18) {
#pragma unroll
            for (int e = 0; e < 8; ++e) cnt[e] = __hip_atomic_load(ecnt + e, __ATOMIC_RELAXED, __HIP_MEMORY_SCOPE_AGENT);
            expert_offsets(cnt, off);
        } else off[8] = 0u;
        const int ntiles = (int)(off[8] >> 8);
        for (int grp = 0; grp < MAXGROUPS; ++grp) {
            const int t0 = grp * GROUP_TILES; int nt = ntiles - t0; nt = nt > GROUP_TILES ? GROUP_TILES : nt;
            if (IN(18 + 2 * grp) && nt > 0) {
                pg8::Gemm g{WSP + WS_GATH + (size_t)t0 * 256 * D, WSP + WS_E13, nt * 256, 2 * DFFE, D};
                pg8::MoeOrder S; S.init(nt * 256, 2 * DFFE, G, wg); S.t0 = t0; for (int q = 0; q < 8; ++q) S.toff[q] = (int)(off[q] >> 8); S.ebytes = (size_t)2 * DFFE * D;
                pg8::EpiPairF8 E{WSP + WS_HID_MOE, DFFE, 1.0f / W13_SCALE};
                pg8::gemm_phase<pg8::EpiPairF8, pg8::MoeOrder, 1>(lds, g, S, E);
            } if (nt > 0) SEAM(18 + 2 * grp);
            if (IN(19 + 2 * grp) && nt > 0) {
                pg8::Gemm g{WSP + WS_HID_MOE, WSP + WS_E2, nt * 256, D, DFFE};
                pg8::MoeOrder S; S.init(nt * 256, D, G, wg); S.t0 = t0; for (int q = 0; q < 8; ++q) S.toff[q] = (int)(off[q] >> 8); S.ebytes = (size_t)D * DFFE;
                pg8::EpiPlainF8 E{WSP + WS_YSLOT + (size_t)t0 * 256 * D, D, 1.0f / W2_SCALE};
                pg8::gemm_phase<pg8::EpiPlainF8, pg8::MoeOrder, 1>(lds, g, S, E);
            } if (nt > 0) SEAM(19 + 2 * grp);
        }
    }
    if (IN(28)) { phase_final(KA()); } SEAM(28);
#undef Hb
#undef Pb
#undef WSP
#undef IN
#undef SEAM
}

extern "C" void kernel_launch(void* const* d_in, const int* in_sizes, int n_in, void* d_out, int out_size, void* d_ws, size_t ws_size, hipStream_t stream) {
    static int grid = 0;
    if (grid == 0) {
        if (n_in != 23 || out_size != ML * D || ws_size < WS_END) { fprintf(stderr, "kernel_launch: unexpected problem (n_in %d, out %d, ws %zu < %zu)\n", n_in, out_size, ws_size, (size_t)WS_END); grid = -1; return; }
        int dev = 0, cus = 0, per_cu = 0;
        if (hipGetDevice(&dev) != hipSuccess || hipDeviceGetAttribute(&cus, hipDeviceAttributeMultiprocessorCount, dev) != hipSuccess) { grid = -1; return; }
        if (hipFuncSetAttribute((const void*)mk_fwd, hipFuncAttributeMaxDynamicSharedMemorySize, LDS_BYTES) != hipSuccess) { fprintf(stderr, "kernel_launch: hipFuncSetAttribute failed\n"); grid = -1; return; }
        if (hipOccupancyMaxActiveBlocksPerMultiprocessor(&per_cu, (const void*)mk_fwd, NTHR, LDS_BYTES) != hipSuccess || per_cu < 1) { fprintf(stderr, "kernel_launch: occupancy query says %d\n", per_cu); }
        (void)hipGetLastError();
        grid = cus;
    }
    if (grid < 0) return;
    hipMemsetAsync((char*)d_ws + WS_CTL, 0, CTL_ZERO_BYTES, stream);
    Args a{};
    for (int i = 0; i < 23; ++i) a.in[i] = (const float*)d_in[i];
    a.out = (float*)d_out; a.ws = (unsigned char*)d_ws;
#if MK_PER_PHASE
    for (int p = 0; p < NPHASE; ++p) { a.ph_lo = p; a.ph_hi = p + 1; hipLaunchKernelGGL(mk_fwd, dim3(grid), dim3(NTHR), LDS_BYTES, stream, a); }
#else
    a.ph_lo = 0; a.ph_hi = NPHASE; hipLaunchKernelGGL(mk_fwd, dim3(grid), dim3(NTHR), LDS_BYTES, stream, a);
#endif
}
```

```cpp
#include <hip/hip_runtime.h>
#include <cstdio>
#include <cstdint>

#ifndef PROBE_MASK
#define PROBE_MASK 0u
#endif
#ifndef MK_PER_PHASE
#define MK_PER_PHASE 0
#endif

namespace pg8 {
#define PG8_LAS __attribute__((address_space(3)))
typedef unsigned short bf16_t;
typedef short bf16x8 __attribute__((ext_vector_type(8)));
typedef float f32x4 __attribute__((ext_vector_type(4)));
typedef unsigned u32x4 __attribute__((ext_vector_type(4)));
typedef unsigned u32x2 __attribute__((ext_vector_type(2)));
typedef int i32x4 __attribute__((ext_vector_type(4)));
typedef int i32x8 __attribute__((ext_vector_type(8)));
constexpr int BM = 256, BK = 64, HALF = 128, HTB = HALF * BK * 2, STAGE_BYTES = 8 * HTB, NXCD = 8, WGM = 8, RINGB = 131072;

__host__ __device__ __forceinline__ int lds_byte(int r, int c) { const int st = (r >> 4) * 2 + (c >> 5), rr = r & 15, cc = c & 31, ob = rr * 64 + cc * 2; return st * 1024 + (ob ^ (((ob >> 9) & 1) << 5)); }
__host__ __device__ __forceinline__ void stage_rc(int b, int& R, int& C) { const int st = b / 1024, sb = b % 1024, swz = sb ^ (((sb >> 9) & 1) << 5); R = (st >> 1) * 16 + swz / 64; C = (st & 1) * 32 + (swz % 64) / 2; }
__host__ __device__ __forceinline__ int perm32(int rho) { const int n = rho >> 4, i = rho & 15; return 8 * (i >> 2) + 4 * n + (i & 3); }

struct Unit { int pm, pn; };
template <bool INT> struct AccT { typedef f32x4 type; };
template <> struct AccT<true> { typedef i32x4 type; };
struct Gemm { const void* A; const void* Bt; int M, N, K; };

struct StaticOrder {
    int nM, nN, nwg, G, c;
    __host__ __device__ void init(int M, int N, int G_, int c_) { nM = M / BM; nN = N / BM; nwg = nM * nN; G = G_; c = c_; }
    __host__ __device__ bool next(int i, Unit& u) const {
        const long L = (long)i * G + c; if (L >= nwg) return false;
        int wgid = (int)L; { const int q = nwg / NXCD, r = nwg % NXCD, xcd = wgid % NXCD, off = wgid / NXCD; wgid = (xcd < r ? xcd * (q + 1) : r * (q + 1) + (xcd - r) * q) + off; }
        const int nig = WGM * nN, gid = wgid / nig, fm = gid * WGM, gsz = (nM - fm) < WGM ? (nM - fm) : WGM;
        u.pm = fm + ((wgid % nig) % gsz); u.pn = (wgid % nig) / gsz; return true;
    }
    __device__ __forceinline__ const char* bptr(const Gemm& g, const Unit& u, size_t tstep) const { return (const char*)g.Bt + (size_t)u.pn * tstep; }
    __device__ __forceinline__ void a_ready(const Unit&) const {}
    __device__ __forceinline__ void done(const Unit&) const {}
};
struct MoeOrder : StaticOrder {
    int t0; int toff[8]; size_t ebytes;
    __device__ __forceinline__ const char* bptr(const Gemm& g, const Unit& u, size_t tstep) const {
        const int t = t0 + u.pm; int e = 0;
#pragma unroll
        for (int q = 1; q < 8; ++q) e += (t >= toff[q]) ? 1 : 0;
        e = __builtin_amdgcn_readfirstlane(e);
        return (const char*)g.Bt + (size_t)e * ebytes + (size_t)u.pn * tstep; }
};

__device__ __forceinline__ unsigned cvt_pk_bf16(float lo, float hi) { unsigned r; asm volatile("v_cvt_pk_bf16_f32 %0, %1, %2" : "=v"(r) : "v"(lo), "v"(hi)); return r; }

struct EpiPlain {
    static constexpr bool PERM = true, AFTER_DRAIN = false, LDS_SCALES = false;
    bf16_t* O; int ldc; float sc = 1.0f;
    __device__ __forceinline__ void operator()(const f32x4 (&acc)[2][2][4][2], const Unit& u, int wr, int wc, int fr, int fq) const {
        const int row0 = u.pm * BM + wr * 64 + fr, col0 = u.pn * BM + wc * 32 + 8 * fq;
#pragma unroll
        for (int ai = 0; ai < 2; ++ai)
#pragma unroll
            for (int m = 0; m < 4; ++m) { bf16_t* rowp = O + (size_t)(row0 + ai * HALF + m * 16) * ldc + col0;
#pragma unroll
                for (int bj = 0; bj < 2; ++bj) { const f32x4 v0 = acc[ai][bj][m][0] * sc, v1 = acc[ai][bj][m][1] * sc;
                    u32x4 w; w.x = cvt_pk_bf16(v0[0], v0[1]); w.y = cvt_pk_bf16(v0[2], v0[3]); w.z = cvt_pk_bf16(v1[0], v1[1]); w.w = cvt_pk_bf16(v1[2], v1[3]);
                    *(u32x4*)(rowp + bj * HALF) = w; } }
    }
};
__device__ __forceinline__ unsigned pk4_fp8(float a, float b, float c, float d);
struct EpiPlainF8 {
    static constexpr bool PERM = true, AFTER_DRAIN = false, LDS_SCALES = false;
    unsigned char* O; int ldc; float sc;
    __device__ __forceinline__ void operator()(const f32x4 (&acc)[2][2][4][2], const Unit& u, int wr, int wc, int fr, int fq) const {
        const int row0 = u.pm * BM + wr * 64 + fr, col0 = u.pn * BM + wc * 32 + 8 * fq;
#pragma unroll
        for (int ai = 0; ai < 2; ++ai)
#pragma unroll
            for (int m = 0; m < 4; ++m) { unsigned char* rowp = O + (size_t)(row0 + ai * HALF + m * 16) * ldc + col0;
#pragma unroll
                for (int bj = 0; bj < 2; ++bj) { const f32x4 v0 = acc[ai][bj][m][0] * sc, v1 = acc[ai][bj][m][1] * sc;
                    u32x2 w; w.x = pk4_fp8(v0[0], v0[1], v0[2], v0[3]); w.y = pk4_fp8(v1[0], v1[1], v1[2], v1[3]);
                    *(u32x2*)(rowp + bj * HALF) = w; } }
    }
};
__device__ __forceinline__ float silu_f(float a) { return a * __builtin_amdgcn_rcpf(1.0f + __builtin_amdgcn_exp2f(-1.44269504f * a)); }
template <int ACT> struct EpiPair {
    static constexpr bool PERM = true, AFTER_DRAIN = false, LDS_SCALES = false;
    bf16_t* O; int ldc;
    __device__ __forceinline__ void operator()(const f32x4 (&acc)[2][2][4][2], const Unit& u, int wr, int wc, int fr, int fq) const {
        const int row0 = u.pm * BM + wr * 64 + fr, col0 = u.pn * HALF + wc * 32 + 8 * fq;
#pragma unroll
        for (int ai = 0; ai < 2; ++ai)
#pragma unroll
            for (int m = 0; m < 4; ++m) { bf16_t* rowp = O + (size_t)(row0 + ai * HALF + m * 16) * ldc + col0;
                f32x4 v0 = acc[ai][0][m][0], v1 = acc[ai][0][m][1]; const f32x4 g0 = acc[ai][1][m][0], g1 = acc[ai][1][m][1];
                if (ACT == 1) {
#pragma unroll
                    for (int j = 0; j < 4; ++j) { v0[j] = silu_f(v0[j]); v1[j] = silu_f(v1[j]); } }
                v0 = v0 * g0; v1 = v1 * g1;
                u32x4 w; w.x = cvt_pk_bf16(v0[0], v0[1]); w.y = cvt_pk_bf16(v0[2], v0[3]); w.z = cvt_pk_bf16(v1[0], v1[1]); w.w = cvt_pk_bf16(v1[2], v1[3]);
                *(u32x4*)rowp = w; }
    }
};
__device__ __forceinline__ unsigned pk4_fp8(float a, float b, float c, float d) {
    a = __builtin_amdgcn_fmed3f(a, -448.f, 448.f); b = __builtin_amdgcn_fmed3f(b, -448.f, 448.f); c = __builtin_amdgcn_fmed3f(c, -448.f, 448.f); d = __builtin_amdgcn_fmed3f(d, -448.f, 448.f);
    int w = 0; w = __builtin_amdgcn_cvt_pk_fp8_f32(a, b, w, false); w = __builtin_amdgcn_cvt_pk_fp8_f32(c, d, w, true); return (unsigned)w; }
struct EpiPairF8 {
    static constexpr bool PERM = true, AFTER_DRAIN = false, LDS_SCALES = false;
    unsigned char* O; int ldc; float sc;
    __device__ __forceinline__ void operator()(const f32x4 (&acc)[2][2][4][2], const Unit& u, int wr, int wc, int fr, int fq) const {
        const int row0 = u.pm * BM + wr * 64 + fr, col0 = u.pn * HALF + wc * 32 + 8 * fq;
        const float c1 = -1.44269504f * sc, c2 = sc * sc;
#pragma unroll
        for (int ai = 0; ai < 2; ++ai)
#pragma unroll
            for (int m = 0; m < 4; ++m) { unsigned char* rowp = O + (size_t)(row0 + ai * HALF + m * 16) * ldc + col0;
                u32x2 w;
#pragma unroll
                for (int n = 0; n < 2; ++n) {
                    const f32x4 A = acc[ai][0][m][n], B = acc[ai][1][m][n];
                    const f32x4 e = A * c1, num = (A * B) * c2;
                    f32x4 den;
#pragma unroll
                    for (int j = 0; j < 4; ++j) den[j] = __builtin_amdgcn_exp2f(e[j]);
                    den = den + 1.0f;
                    f32x4 o;
#pragma unroll
                    for (int j = 0; j < 4; ++j) o[j] = __builtin_amdgcn_rcpf(den[j]);
                    o = o * num;
                    w[n] = pk4_fp8(o[0], o[1], o[2], o[3]); }
                *(u32x2*)rowp = w; }
    }
};
constexpr int SCL_OFF = RINGB + 1024;
struct LdsScales {
    const float* sa; const float* sb; PG8_LAS unsigned char* lds;
    __device__ __forceinline__ void stage(const Unit& u, int par, int wid, int lane) const {
        const float* src = (wid < 4) ? sa + (size_t)u.pm * BM + wid * 64 + lane : sb + (size_t)u.pn * BM + (wid - 4) * 64 + lane;
        __builtin_amdgcn_global_load_lds((const unsigned*)src, (PG8_LAS unsigned*)(lds + SCL_OFF + par * 2048 + wid * 256), 4, 0, 0);
    }
    __device__ __forceinline__ float row_scale(int par, int rl) const { return *(const PG8_LAS float*)(lds + SCL_OFF + par * 2048 + rl * 4); }
    __device__ __forceinline__ f32x4 col_scale4(int par, int cl) const { return *(const PG8_LAS f32x4*)(lds + SCL_OFF + par * 2048 + 1024 + cl * 4); }
};
template <int OUT8> struct EpiPairI8 {
    static constexpr bool PERM = true, AFTER_DRAIN = false, LDS_SCALES = true;
    bf16_t* O; int ldc; LdsScales L;
    __device__ __forceinline__ void operator()(const i32x4 (&acc)[2][2][4][2], const Unit& u, int wr, int wc, int fr, int fq, int par) const {
        const int col0 = u.pn * HALF + wc * 32 + 8 * fq, cl0 = wc * 32 + 8 * fq;
        f32x4 c1[2], c2[2];
#pragma unroll
        for (int n = 0; n < 2; ++n) { const f32x4 sa = L.col_scale4(par, cl0 + 4 * n), sg = L.col_scale4(par, cl0 + HALF + 4 * n); c1[n] = sa * -1.44269504f; c2[n] = sa * sg; }
#pragma unroll
        for (int ai = 0; ai < 2; ++ai)
#pragma unroll
            for (int m = 0; m < 4; ++m) { const int rl = wr * 64 + fr + ai * HALF + m * 16; const float ra = L.row_scale(par, rl), ra2 = ra * ra;
                f32x4 o[2];
#pragma unroll
                for (int n = 0; n < 2; ++n) {
                    const f32x4 A = __builtin_convertvector(acc[ai][0][m][n], f32x4), G = __builtin_convertvector(acc[ai][1][m][n], f32x4);
                    const f32x4 e = A * (c1[n] * ra), num = (A * G) * (c2[n] * ra2);
                    f32x4 den;
#pragma unroll
                    for (int j = 0; j < 4; ++j) den[j] = __builtin_amdgcn_exp2f(e[j]);
                    den = den + 1.0f;
#pragma unroll
                    for (int j = 0; j < 4; ++j) o[n][j] = __builtin_amdgcn_rcpf(den[j]);
                    o[n] = o[n] * num; }
                if constexpr (OUT8) { u32x2 w; w.x = pk4_fp8(o[0][0], o[0][1], o[0][2], o[0][3]); w.y = pk4_fp8(o[1][0], o[1][1], o[1][2], o[1][3]);
                    *(u32x2*)((unsigned char*)O + (size_t)(u.pm * BM + rl) * ldc + col0) = w; }
                else { u32x4 w; w.x = cvt_pk_bf16(o[0][0], o[0][1]); w.y = cvt_pk_bf16(o[0][2], o[0][3]); w.z = cvt_pk_bf16(o[1][0], o[1][1]); w.w = cvt_pk_bf16(o[1][2], o[1][3]);
                    *(u32x4*)(O + (size_t)(u.pm * BM + rl) * ldc + col0) = w; } }
    }
};
struct EpiInProj {
    static constexpr bool PERM = true, AFTER_DRAIN = false, LDS_SCALES = false;
    bf16_t* O; int ldc;
    __device__ __forceinline__ void operator()(const f32x4 (&acc)[2][2][4][2], const Unit& u, int wr, int wc, int fr, int fq) const {
        if (u.pn >= 8 && u.pn < 12) { Unit v; v.pm = u.pm; v.pn = u.pn - 8; EpiPair<0> E{O + 2048, ldc}; E(acc, v, wr, wc, fr, fq); }
        else { Unit v; v.pm = u.pm; v.pn = (u.pn == 12) ? 10 : u.pn; EpiPlain E{O, ldc}; E(acc, v, wr, wc, fr, fq); }
    }
};

struct EpiInProjI8 {
    static constexpr bool PERM = true, AFTER_DRAIN = false, LDS_SCALES = true;
    bf16_t* O; int ldc; LdsScales L;
    __device__ __forceinline__ void operator()(const i32x4 (&acc)[2][2][4][2], const Unit& u, int wr, int wc, int fr, int fq, int par) const {
        const int cl0 = wc * 32 + 8 * fq;
        f32x4 sv[2][2];
#pragma unroll
        for (int bj = 0; bj < 2; ++bj)
#pragma unroll
            for (int n = 0; n < 2; ++n) sv[bj][n] = L.col_scale4(par, cl0 + bj * HALF + 4 * n);
        if (u.pn >= 8 && u.pn < 12) {
            const int col0 = 2048 + (u.pn - 8) * HALF + wc * 32 + 8 * fq;
#pragma unroll
            for (int ai = 0; ai < 2; ++ai)
#pragma unroll
                for (int m = 0; m < 4; ++m) { const int rl = wr * 64 + fr + ai * HALF + m * 16; bf16_t* rowp = O + (size_t)(u.pm * BM + rl) * ldc + col0; const float ra = L.row_scale(par, rl);
                    const float ra2 = ra * ra;
                    const f32x4 v0 = (__builtin_convertvector(acc[ai][0][m][0], f32x4) * __builtin_convertvector(acc[ai][1][m][0], f32x4)) * ((sv[0][0] * sv[1][0]) * ra2);
                    const f32x4 v1 = (__builtin_convertvector(acc[ai][0][m][1], f32x4) * __builtin_convertvector(acc[ai][1][m][1], f32x4)) * ((sv[0][1] * sv[1][1]) * ra2);
                    u32x4 w; w.x = cvt_pk_bf16(v0[0], v0[1]); w.y = cvt_pk_bf16(v0[2], v0[3]); w.z = cvt_pk_bf16(v1[0], v1[1]); w.w = cvt_pk_bf16(v1[2], v1[3]);
                    *(u32x4*)rowp = w; }
        } else {
            const int col0 = ((u.pn == 12) ? 10 : u.pn) * BM + wc * 32 + 8 * fq;
            const int nbj = (u.pn == 12) ? (wc == 0 ? 1 : 0) : 2;
#pragma unroll
            for (int ai = 0; ai < 2; ++ai)
#pragma unroll
                for (int m = 0; m < 4; ++m) { const int rl = wr * 64 + fr + ai * HALF + m * 16; bf16_t* rowp = O + (size_t)(u.pm * BM + rl) * ldc + col0; const float ra = L.row_scale(par, rl);
#pragma unroll
                    for (int bj = 0; bj < 2; ++bj) { if (bj >= nbj) continue;
                        const f32x4 v0 = __builtin_convertvector(acc[ai][bj][m][0], f32x4) * (sv[bj][0] * ra), v1 = __builtin_convertvector(acc[ai][bj][m][1], f32x4) * (sv[bj][1] * ra);
                        u32x4 w; w.x = cvt_pk_bf16(v0[0], v0[1]); w.y = cvt_pk_bf16(v0[2], v0[3]); w.z = cvt_pk_bf16(v1[0], v1[1]); w.w = cvt_pk_bf16(v1[2], v1[3]);
                        *(u32x4*)(rowp + bj * HALF) = w; } }
        }
    }
};

template <class Epi, class Sched, int MODE = 0  >
__device__ __forceinline__ void gemm_phase(PG8_LAS unsigned char* lds, const Gemm g, const Sched& S, const Epi& E) {
    constexpr bool ALIGN_EPI = true;
    int tid_ = threadIdx.x; asm volatile("" : "+v"(tid_));
    const int tid = tid_, wid = __builtin_amdgcn_readfirstlane(tid >> 6), lane = tid & 63, wr = wid >> 2, wc = wid & 3, fr = lane & 15, fq = lane >> 4;
    constexpr bool FP8 = (MODE == 1), I8 = (MODE == 2);
    const int K = (MODE != 0) ? g.K / 2 : g.K, nt = K / BK;
    unsigned voffA[2], voffB[2];
#pragma unroll
    for (int i = 0; i < 2; ++i) { int R, C; stage_rc(tid * 16 + i * 8192, R, C); const int Rb = Epi::PERM ? ((R & ~31) + perm32(R & 31)) : R;
        voffA[i] = (unsigned)(R * K + C) * 2u; voffB[i] = (unsigned)(Rb * K + C) * 2u; }
    const size_t kstep = (size_t)(BK * 2);
    const size_t hstep = (size_t)HALF * K * 2;
    const size_t tstep = 2 * hstep;
    const unsigned ldsw = (unsigned)wid * 1024u;
    const int aoff = lds_byte(wr * 64 + fr, fq * 8), boff = lds_byte(wc * 32 + fr, fq * 8);
#define PG8_SA(b, h) (((b) * 2 + (h)) * HTB)
#define PG8_SB(b, h) ((4 + (b) * 2 + (h)) * HTB)
#define PG8_STAGE(bufoff, gbase, voff) do { _Pragma("unroll") for (int _i = 0; _i < 2; ++_i) \
        __builtin_amdgcn_global_load_lds((const unsigned*)((const char*)(gbase) + (voff)[_i]), (PG8_LAS unsigned*)(lds + (bufoff) + ldsw + _i * 8192), 16, 0, 0); } while (0)
#define PG8_LDA(dst, b, h) do { _Pragma("unroll") for (int m = 0; m < 4; ++m) _Pragma("unroll") for (int k = 0; k < 2; ++k) dst[m][k] = *(const PG8_LAS bf16x8*)(lds + PG8_SA(b, h) + aoff + m * 2048 + k * 1024); } while (0)
#define PG8_LDB(dst, b, h) do { _Pragma("unroll") for (int n = 0; n < 2; ++n) _Pragma("unroll") for (int k = 0; k < 2; ++k) dst[n][k] = *(const PG8_LAS bf16x8*)(lds + PG8_SB(b, h) + boff + n * 2048 + k * 1024); } while (0)
#define PG8_MMA(ai, bj, At, Bt) do { __builtin_amdgcn_s_setprio(1); _Pragma("unroll") for (int m = 0; m < 4; ++m) _Pragma("unroll") for (int n = 0; n < 2; ++n) _Pragma("unroll") for (int k = 0; k < 2; ++k) \
        acc[ai][bj][m][n] = __builtin_amdgcn_mfma_f32_16x16x32_bf16(Bt[n][k], At[m][k], acc[ai][bj][m][n], 0, 0, 0); __builtin_amdgcn_s_setprio(0); } while (0)
#define PG8_MMA8(ai, bj, At, Bt) do { __builtin_amdgcn_s_setprio(1); _Pragma("unroll") for (int m = 0; m < 4; ++m) _Pragma("unroll") for (int n = 0; n < 2; ++n) { \
        const i32x8 bop_ = __builtin_shufflevector(__builtin_bit_cast(i32x4, Bt[n][0]), __builtin_bit_cast(i32x4, Bt[n][1]), 0, 1, 2, 3, 4, 5, 6, 7); \
        const i32x8 aop_ = __builtin_shufflevector(__builtin_bit_cast(i32x4, At[m][0]), __builtin_bit_cast(i32x4, At[m][1]), 0, 1, 2, 3, 4, 5, 6, 7); \
        asm volatile("v_mfma_f32_16x16x128_f8f6f4 %0, %1, %2, %0" : "+v"(acc[ai][bj][m][n]) : "v"(bop_), "v"(aop_)); } __builtin_amdgcn_s_setprio(0); } while (0)
#define PG8_MMAI(ai, bj, At, Bt) do { __builtin_amdgcn_s_setprio(1); _Pragma("unroll") for (int m = 0; m < 4; ++m) _Pragma("unroll") for (int n = 0; n < 2; ++n) _Pragma("unroll") for (int k = 0; k < 2; ++k) \
        acc[ai][bj][m][n] = __builtin_amdgcn_mfma_i32_16x16x64_i8(__builtin_bit_cast(i32x4, Bt[n][k]), __builtin_bit_cast(i32x4, At[m][k]), acc[ai][bj][m][n], 0, 0, 0); \
        __builtin_amdgcn_s_setprio(0); } while (0)
#define PG8_MM(ai, bj, At, Bt) do { if constexpr (FP8) PG8_MMA8(ai, bj, At, Bt); else if constexpr (I8) PG8_MMAI(ai, bj, At, Bt); else PG8_MMA(ai, bj, At, Bt); } while (0)
#define PG8_WAIT_V(n) asm volatile("s_waitcnt vmcnt(" #n ")" ::: "memory")
#define PG8_WAIT_L(n) asm volatile("s_waitcnt lgkmcnt(" #n ")" ::: "memory")
#define PG8_BAR __builtin_amdgcn_s_barrier()
#define PG8_SCHED __builtin_amdgcn_sched_barrier(0)
    Unit cur, nxt; int ui = 0;
    if (!S.next(0, cur)) return;
    int scale1_ = 0x7f7f7f7f; asm volatile("" : "+v"(scale1_)); (void)scale1_;
    typedef typename AccT<MODE == 2>::type acc_t;
    acc_t acc[2][2][4][2];
#pragma unroll
    for (int a = 0; a < 2; ++a)
#pragma unroll
        for (int b = 0; b < 2; ++b)
#pragma unroll
            for (int m = 0; m < 4; ++m)
#pragma unroll
                for (int n = 0; n < 2; ++n) acc[a][b][m][n] = (acc_t){0, 0, 0, 0};
    bf16x8 At[4][2], B0[2][2], B1[2][2];
    const char* cA = (const char*)g.A + (size_t)cur.pm * tstep; const char* cB = S.bptr(g, cur, tstep);
    S.a_ready(cur);
    if constexpr (Epi::LDS_SCALES) E.L.stage(cur, 0, wid, lane);
    PG8_STAGE(PG8_SB(0, 0), cB, voffB); PG8_STAGE(PG8_SB(0, 1), cB + hstep, voffB); PG8_STAGE(PG8_SA(0, 0), cA, voffA); PG8_STAGE(PG8_SA(0, 1), cA + hstep, voffA);
    if (wr == 1) PG8_BAR;
    PG8_WAIT_V(2); PG8_BAR;
    PG8_STAGE(PG8_SB(1, 0), cB + kstep, voffB); PG8_STAGE(PG8_SA(1, 0), cA + kstep, voffA); PG8_STAGE(PG8_SB(1, 1), cB + hstep + kstep, voffB);
    PG8_WAIT_V(6); PG8_BAR;
    for (;;) {
        const bool has_next = S.next(ui + 1, nxt);
        const char* nA = has_next ? (const char*)g.A + (size_t)nxt.pm * tstep : cA; const char* nB = has_next ? S.bptr(g, nxt, tstep) : cB;
        for (int t = 0; t < nt; t += 2) {
            const bool last = (t == nt - 2);
            const char* a1 = cA + (size_t)(t + 1) * kstep;
            const char* a2 = last ? nA : cA + (size_t)(t + 2) * kstep; const char* b2 = last ? nB : cB + (size_t)(t + 2) * kstep;
            const char* a3 = a2 + kstep; const char* b3 = b2 + kstep;
            if (last && has_next) S.a_ready(nxt);
            PG8_LDB(B0, 0, 0); PG8_LDB(B1, 0, 1); PG8_SCHED; PG8_LDA(At, 0, 0); PG8_STAGE(PG8_SA(1, 1), a1 + hstep, voffA);
            PG8_WAIT_V(8); PG8_WAIT_L(0); PG8_BAR; PG8_MM(0, 0, At, B0); PG8_MM(0, 1, At, B1); PG8_BAR; PG8_SCHED;
            PG8_LDA(At, 0, 1); PG8_STAGE(PG8_SB(0, 0), b2, voffB); PG8_STAGE(PG8_SB(0, 1), b2 + hstep, voffB); PG8_STAGE(PG8_SA(0, 0), a2, voffA);
            PG8_WAIT_V(8); PG8_WAIT_L(0); PG8_BAR; PG8_MM(1, 0, At, B0); PG8_MM(1, 1, At, B1); PG8_BAR; PG8_SCHED;
            PG8_LDB(B0, 1, 0); PG8_LDB(B1, 1, 1); PG8_SCHED; PG8_LDA(At, 1, 0); PG8_STAGE(PG8_SA(0, 1), a2 + hstep, voffA);
            PG8_WAIT_V(8); PG8_WAIT_L(0); PG8_BAR; PG8_MM(0, 0, At, B0); PG8_MM(0, 1, At, B1); PG8_BAR; PG8_SCHED;
            PG8_LDA(At, 1, 1); PG8_STAGE(PG8_SB(1, 0), b3, voffB); PG8_STAGE(PG8_SB(1, 1), b3 + hstep, voffB); PG8_STAGE(PG8_SA(1, 0), a3, voffA);
            PG8_WAIT_V(8); PG8_WAIT_L(0); PG8_BAR; PG8_MM(1, 0, At, B0); PG8_MM(1, 1, At, B1); PG8_BAR; PG8_SCHED;
        }
        if constexpr (ALIGN_EPI) { if (wr == 0) PG8_BAR; }
        if constexpr (FP8) asm volatile("s_nop 15\n\ts_nop 15" ::: "memory");
        if constexpr (Epi::LDS_SCALES) E(acc, cur, wr, wc, fr, fq, ui & 1); else E(acc, cur, wr, wc, fr, fq);
        S.done(cur);
        if (!has_next) break;
        if constexpr (Epi::LDS_SCALES) E.L.stage(nxt, (ui + 1) & 1, wid, lane);
#pragma unroll
        for (int a = 0; a < 2; ++a)
#pragma unroll
            for (int b = 0; b < 2; ++b)
#pragma unroll
                for (int m = 0; m < 4; ++m)
#pragma unroll
                    for (int n = 0; n < 2; ++n) { typedef unsigned long long u64x2_ __attribute__((ext_vector_type(2))); u64x2_ z;
                        asm volatile("v_mov_b64 %0, 0" : "=v"(z.x)); asm volatile("v_mov_b64 %0, 0" : "=v"(z.y)); acc[a][b][m][n] = __builtin_bit_cast(acc_t, z); }
        cur = nxt; cA = nA; cB = nB; ++ui;
        if constexpr (ALIGN_EPI) { if (wr == 1) PG8_BAR; }
    }
    PG8_WAIT_V(0);
    if constexpr (!ALIGN_EPI) { if (wr == 0) PG8_BAR; }
    PG8_BAR;
#undef PG8_SA
#undef PG8_SB
#undef PG8_STAGE
#undef PG8_LDA
#undef PG8_LDB
#undef PG8_MMA
#undef PG8_MMA8
#undef PG8_MMAI
#undef PG8_MM
#undef PG8_WAIT_V
#undef PG8_WAIT_L
#undef PG8_BAR
#undef PG8_SCHED
}
}

constexpr int NWAVES = 8, NTHR = 512;
constexpr int D = 1024, NB = 16, SEQ = 4096, CTXL = 256;
constexpr int ML = NB * SEQ;
constexpr int MC = NB * CTXL;
constexpr int MT = ML + MC;
constexpr int NPROJ_SRC = 3104;
constexpr int NPROJ = 3328;
constexpr int LDP = 2816;
constexpr int PQ = 0, PK = 256, PV = 512, PGT = 1024, PB = 1536, PU = 2048, PA = 2560;
constexpr int DFF = 2816, NEXP = 8, DFFE = 3584;
constexpr int NCHUNK = MT / 64;
constexpr int MAXSLOT = 2 * ML + NEXP * 256;
constexpr int MAXTILE = MAXSLOT / 256;
constexpr int GROUP_TILES = MAXTILE;
constexpr int MAXGROUPS = 1;
constexpr float EPS = 1e-6f;
constexpr float W13_SCALE = 64.0f, W2_SCALE = 128.0f;

constexpr size_t MiB = 1u << 20;
constexpr size_t WS_CTL = 0, CTL_ZERO_BYTES = 128 * 1024;
constexpr size_t WS_MOD = 1 * MiB;
constexpr size_t WS_DC = 2 * MiB;
constexpr size_t WS_TOK = 5 * MiB;
constexpr size_t WS_SA = 7 * MiB;
constexpr size_t WS_SB13 = 7 * MiB + 512 * 1024;
constexpr size_t WS_SBIN = 7 * MiB + 576 * 1024;
constexpr size_t WS_WIN = 8 * MiB;
constexpr size_t WS_WOUT = WS_WIN + (size_t)2 * NPROJ * D * 2;
constexpr size_t WS_W13 = WS_WOUT + (size_t)2 * D * D * 2;
constexpr size_t WS_W2 = WS_W13 + (size_t)2 * DFF * D * 2;
constexpr size_t WS_E13 = WS_W2 + (size_t)D * DFF * 2;
constexpr size_t WS_E2 = WS_E13 + (size_t)NEXP * 2 * DFFE * D;
constexpr size_t WS_XC = WS_E2 + (size_t)NEXP * D * DFFE;
constexpr size_t WS_H = WS_XC + (size_t)MC * D * 4;
constexpr size_t WS_US = WS_H + (size_t)MT * D * 2;
constexpr size_t WS_P = WS_US + (size_t)NCHUNK * 8 * 8192 * 2;
constexpr size_t WS_HID_MOE = WS_H;
constexpr size_t WS_YSLOT = WS_HID_MOE + (size_t)MAXSLOT * DFFE;
constexpr size_t WS_GATH = WS_YSLOT + (size_t)MAXSLOT * D * 2;
constexpr size_t WS_END = WS_GATH + (size_t)MAXSLOT * D;
constexpr size_t WS_U8 = WS_GATH;
static_assert((size_t)NCHUNK * 8 * 8192 <= (size_t)MAXSLOT * D, "U8 fits the gathered-row region");
static_assert(WS_GATH >= WS_P + (size_t)MT * LDP * 2, "gathered rows must not overlap the P region");
static_assert(WS_END <= (size_t)1024 * MiB, "workspace");
constexpr size_t TOK_E = 0;
constexpr size_t TOK_W = 256 * 1024;
constexpr size_t TOK_RANK = 768 * 1024;
constexpr size_t TOK_SLOT = 1280 * 1024;
constexpr size_t TOK_WGBASE = 1792 * 1024;
constexpr size_t TOK_TEXP = 1800 * 1024;
constexpr int CW_BAR = 4096;
constexpr int CW_ECNT = 8192;
constexpr int CW_CMAX13 = 16384;
constexpr int CW_CMAXIN = 24576;

static_assert((size_t)(CW_CMAXIN + 2 * NPROJ) * 4 <= CTL_ZERO_BYTES && (size_t)(CW_CMAX13 + 2 * DFF) * 4 <= (size_t)CW_CMAXIN * 4, "control words inside the per-call memset");
#define GAS __attribute__((address_space(1)))
#define CAS __attribute__((address_space(4)))
#define LAS __attribute__((address_space(3)))
typedef unsigned short bf16;
typedef float f32x4 __attribute__((ext_vector_type(4)));
typedef unsigned u32x4 __attribute__((ext_vector_type(4)));
typedef unsigned u32x2 __attribute__((ext_vector_type(2)));
typedef short bf16x8 __attribute__((ext_vector_type(8)));
#define LDS_WAIT() asm volatile("s_waitcnt lgkmcnt(0)" ::: "memory")
#define LDS_BARRIER() do { asm volatile("s_waitcnt lgkmcnt(0)" ::: "memory"); __builtin_amdgcn_s_barrier(); asm volatile("" ::: "memory"); } while (0)

__device__ __forceinline__ unsigned f2bf(float f) { unsigned u = __builtin_bit_cast(unsigned, f); return (u + 0x7fffu + ((u >> 16) & 1u)) >> 16; }
__device__ __forceinline__ unsigned pk2(float lo, float hi) { unsigned r; asm("v_cvt_pk_bf16_f32 %0, %1, %2" : "=v"(r) : "v"(lo), "v"(hi)); return r; }
__device__ __forceinline__ unsigned pk2_sw(float lo, float hi) { return f2bf(lo) | (f2bf(hi) << 16); }
__device__ __forceinline__ float bflo(unsigned w) { return __builtin_bit_cast(float, w << 16); }
__device__ __forceinline__ float bfhi(unsigned w) { return __builtin_bit_cast(float, w & 0xffff0000u); }
__device__ __forceinline__ float bf2f(unsigned short b) { return __builtin_bit_cast(float, ((unsigned)b) << 16); }
template <int CTRL, int RM> __device__ __forceinline__ float dpp0f(float v) { return __builtin_bit_cast(float, __builtin_amdgcn_update_dpp(0, __builtin_bit_cast(int, v), CTRL, RM, 0xf, true)); }
__device__ __forceinline__ float wave_sum(float v) {
    v += dpp0f<0x111, 0xf>(v); v += dpp0f<0x112, 0xf>(v); v += dpp0f<0x114, 0xf>(v); v += dpp0f<0x118, 0xf>(v);
    v += dpp0f<0x142, 0xa>(v); v += dpp0f<0x143, 0xc>(v);
    return __builtin_bit_cast(float, __builtin_amdgcn_readlane(__builtin_bit_cast(int, v), 63));
}
__device__ __forceinline__ float wave_max_nonneg(float v) {
    v = fmaxf(v, dpp0f<0x111, 0xf>(v)); v = fmaxf(v, dpp0f<0x112, 0xf>(v)); v = fmaxf(v, dpp0f<0x114, 0xf>(v)); v = fmaxf(v, dpp0f<0x118, 0xf>(v));
    v = fmaxf(v, dpp0f<0x142, 0xa>(v)); v = fmaxf(v, dpp0f<0x143, 0xc>(v));
    return __builtin_bit_cast(float, __builtin_amdgcn_readlane(__builtin_bit_cast(int, v), 63));
}

#define XB_TMO      128
#define XB_XCNT(j)  (256  + 64 * (j))
#define XB_XSUB(j)  (1280 + 64 * (j))
#define XB_XGEN(j)  (2304 + 64 * (j))
#define XB_TOP      3328
#define XB_TOPGEN   3392
#define XCD_BAR_WORDS 3456
#define XB_SPIN_CAP (1u << 22)
__device__ __forceinline__ unsigned xb_ld(unsigned* p)              { return __hip_atomic_load((GAS unsigned*)p, __ATOMIC_RELAXED, __HIP_MEMORY_SCOPE_AGENT); }
__device__ __forceinline__ unsigned xb_add(unsigned* p, unsigned v) { return __hip_atomic_fetch_add((GAS unsigned*)p, v, __ATOMIC_RELAXED, __HIP_MEMORY_SCOPE_AGENT); }
__device__ __forceinline__ unsigned xb_xcc_id() { return (unsigned)__builtin_amdgcn_s_getreg((3 << 11) | 20) & 0xFu; }
#define XB_SPIN(cond, bar) do { unsigned _sp = 0; while (cond) { __builtin_amdgcn_s_sleep(1); \
    if ((++_sp & 255u) == 0u) { if (xb_ld(&(bar)[XB_TMO])) break; if (_sp > XB_SPIN_CAP) { atomicAdd(&(bar)[XB_TMO], 1u); break; } } } } while (0)
struct XcdBarrier { unsigned* bar; unsigned x; volatile LAS unsigned* st; };
__device__ __forceinline__ XcdBarrier xcd_barrier_post(unsigned* bar, volatile LAS unsigned* st) {
    XcdBarrier b; b.bar = bar; b.x = xb_xcc_id(); b.st = st;
    if (threadIdx.x == 0) (void)xb_add(&bar[XB_XCNT(b.x)], 1u);
    return b;
}
__device__ __forceinline__ void xcd_barrier_complete(unsigned* bar, unsigned x, unsigned& nloc, unsigned& nx) {
    const unsigned G = gridDim.x * gridDim.y * gridDim.z;
    unsigned sum, cnt, mine, sp = 0u;
    for (;;) {
        sum = 0u; cnt = 0u; mine = 0u;
#pragma unroll
        for (unsigned j = 0; j < 16; ++j) { const unsigned c = xb_ld(&bar[XB_XCNT(j)]); sum += c; cnt += (c > 0u) ? 1u : 0u; mine = (j == x) ? c : mine; }
        if (sum == G) break;
        __builtin_amdgcn_s_sleep(1);
        if ((++sp & 255u) == 0u) { if (xb_ld(&bar[XB_TMO])) break; if (sp > XB_SPIN_CAP) { atomicAdd(&bar[XB_TMO], 1u); break; } }
    }
    nloc = mine > 0u ? mine : 1u; nx = cnt > 0u ? cnt : 1u;
}
__device__ __forceinline__ void xcd_barrier(const XcdBarrier& b) {
    asm volatile("s_waitcnt vmcnt(0)" ::: "memory");
    __syncthreads();
    if (threadIdx.x == 0) {
        unsigned* bar = b.bar;
        __builtin_amdgcn_s_waitcnt(0);
        unsigned nloc = b.st[0], nx = b.st[1];
        if (nloc == 0u) { xcd_barrier_complete(bar, b.x, nloc, nx); b.st[0] = nloc; b.st[1] = nx; }
        const unsigned old = xb_add(&bar[XB_XSUB(b.x)], 1u);
        const unsigned gen = old / nloc;
        if (old + 1u == (gen + 1u) * nloc) {
            __builtin_amdgcn_fence(__ATOMIC_RELEASE, "agent");
            asm volatile("s_waitcnt vmcnt(0)" ::: "memory");
            const unsigned og = xb_add(&bar[XB_TOP], 1u);
            const unsigned tg = og / nx;
            if (og + 1u == (tg + 1u) * nx) xb_add(&bar[XB_TOPGEN], 1u);
            else XB_SPIN(xb_ld(&bar[XB_TOPGEN]) == tg, bar);
            __builtin_amdgcn_fence(__ATOMIC_ACQUIRE, "agent");
            xb_add(&bar[XB_XGEN(b.x)], 1u);
            asm volatile("s_waitcnt vmcnt(0)" ::: "memory");
        } else {
            XB_SPIN(xb_ld(&bar[XB_XGEN(b.x)]) == gen, bar);
            __builtin_amdgcn_fence(__ATOMIC_ACQUIRE, "agent");
            asm volatile("s_waitcnt vmcnt(0)" ::: "memory");
        }
    }
    __syncthreads();
}

constexpr int RING_BYTES = 131072;
constexpr int LDSCTL_OFF = RING_BYTES;
constexpr int LDS_BYTES = 147456;

struct Args {
    const float* in[23]; float* out; unsigned char* ws; int ph_lo, ph_hi;
};
struct DArgs {
    const __attribute__((address_space(1))) float* in[23]; __attribute__((address_space(1))) float* out; __attribute__((address_space(1))) unsigned char* ws; int ph_lo, ph_hi;
};
static_assert(sizeof(Args) == sizeof(DArgs), "Args layout");

__device__ __forceinline__ int fresh_tid() { int t = threadIdx.x; asm volatile("" : "+v"(t)); return t; }
#define PHASE_IDS() const int tid = fresh_tid(), lane = tid & 63, wave = __builtin_amdgcn_readfirstlane(tid >> 6); const int G = gridDim.x, wg = blockIdx.x; \
    const int vcu = (G % 8 == 0) ? (wg % 8) * (G / 8) + wg / 8 : wg; const int gw = vcu * NWAVES + wave, NGW = G * NWAVES; (void)tid; (void)lane; (void)wave; (void)vcu; (void)gw; (void)NGW;
#define AIN(k) ((const float*)a.in[k])
#define AOUT ((float*)a.out)
#define AWS ((unsigned char*)a.ws)
struct Row { f32x4 v[4]; };
__device__ __forceinline__ Row ld_row_f32(const float* p, int lane) { Row r;
#pragma unroll
    for (int j = 0; j < 4; ++j) r.v[j] = *(const f32x4*)(p + 256 * j + 4 * lane);
    return r; }
__device__ __forceinline__ Row ld_row_bf16(const bf16* p, int lane) { Row r;
#pragma unroll
    for (int j = 0; j < 4; ++j) { const u32x2 w = *(const u32x2*)(p + 256 * j + 4 * lane); r.v[j] = (f32x4){bflo(w.x), bfhi(w.x), bflo(w.y), bfhi(w.y)}; }
    return r; }
__device__ __forceinline__ Row ld_row_fp8(const unsigned char* p, int lane) { Row r;
    typedef float f32x2_ __attribute__((ext_vector_type(2)));
#pragma unroll
    for (int j = 0; j < 4; ++j) { const int w = *(const int*)(p + 256 * j + 4 * lane); const f32x2_ a = __builtin_amdgcn_cvt_pk_f32_fp8(w, false), b = __builtin_amdgcn_cvt_pk_f32_fp8(w, true);
        r.v[j] = (f32x4){a.x, a.y, b.x, b.y}; }
    return r; }
__device__ __forceinline__ void st_row_f32(float* p, int lane, const Row& r) {
#pragma unroll
    for (int j = 0; j < 4; ++j) *(f32x4*)(p + 256 * j + 4 * lane) = r.v[j]; }
__device__ __forceinline__ void st_row_bf16(bf16* p, int lane, const Row& r) {
#pragma unroll
    for (int j = 0; j < 4; ++j) { u32x2 w; w.x = pk2(r.v[j][0], r.v[j][1]); w.y = pk2(r.v[j][2], r.v[j][3]); *(u32x2*)(p + 256 * j + 4 * lane) = w; } }
__device__ __forceinline__ void st_row_fp8(unsigned char* p, int lane, const Row& r) {
#pragma unroll
    for (int j = 0; j < 4; ++j) *(unsigned*)(p + 256 * j + 4 * lane) = pg8::pk4_fp8(r.v[j][0], r.v[j][1], r.v[j][2], r.v[j][3]); }
__device__ __forceinline__ float wave_max(float v) {
#pragma unroll
    for (int o = 1; o < 64; o <<= 1) v = fmaxf(v, __shfl_xor(v, o));
    return v;
}
__device__ __forceinline__ void st_row_i8(unsigned char* p, float* sa, int lane, const Row& r) {
    float mx = 0.f;
#pragma unroll
    for (int j = 0; j < 4; ++j) mx = fmaxf(fmaxf(mx, fmaxf(fabsf(r.v[j][0]), fabsf(r.v[j][1]))), fmaxf(fabsf(r.v[j][2]), fabsf(r.v[j][3])));
    mx = wave_max_nonneg(mx);
    const float inv = mx > 0.f ? 127.0f * __builtin_amdgcn_rcpf(mx) : 0.f;
#pragma unroll
    for (int j = 0; j < 4; ++j) {
        const unsigned t0 = __builtin_bit_cast(unsigned, __builtin_fmaf(r.v[j][0], inv, 12582912.0f)), t1 = __builtin_bit_cast(unsigned, __builtin_fmaf(r.v[j][1], inv, 12582912.0f));
        const unsigned t2 = __builtin_bit_cast(unsigned, __builtin_fmaf(r.v[j][2], inv, 12582912.0f)), t3 = __builtin_bit_cast(unsigned, __builtin_fmaf(r.v[j][3], inv, 12582912.0f));
        const unsigned p01 = __builtin_amdgcn_perm(t1, t0, 0x0c0c0400u), p23 = __builtin_amdgcn_perm(t3, t2, 0x0c0c0400u);
        *(unsigned*)(p + 256 * j + 4 * lane) = __builtin_amdgcn_perm(p23, p01, 0x05040100u); }
    (void)lane; *sa = mx > 0.f ? mx * (1.0f / 127.0f) : 1.0f;
}
__device__ __forceinline__ float row_rstd(const Row& r) { float s = 0.f;
#pragma unroll
    for (int j = 0; j < 4; ++j) s += (r.v[j][0] * r.v[j][0] + r.v[j][1] * r.v[j][1]) + (r.v[j][2] * r.v[j][2] + r.v[j][3] * r.v[j][3]);
    return __builtin_amdgcn_rsqf(wave_sum(s) * (1.0f / D) + EPS); }
#define XR(r) ((bf16*)((unsigned char*)AOUT + (size_t)(r) * 4096))
__device__ __forceinline__ const float* modp(const float* MOD, int l, int bb, int which) { return MOD + ((size_t)(l * 17 + bb) * 6 + which) * D; }
__device__ __forceinline__ int row_bb(int r) { return r < ML ? (r >> 12) : 16; }
struct RawB { u32x2 w[4]; };
struct RawF { u32x4 q[4]; };
__device__ __forceinline__ void ldraw_bf16(RawB& o, const bf16* p, int lane) {
#pragma unroll
    for (int j = 0; j < 4; ++j) o.w[j] = *(const u32x2*)(p + 256 * j + 4 * lane); }
__device__ __forceinline__ void ldraw_f32(RawF& o, const float* p, int lane) {
#pragma unroll
    for (int j = 0; j < 4; ++j) o.q[j] = *(const u32x4*)(p + 256 * j + 4 * lane); }
__device__ __forceinline__ void ldraw_bf16(RawF& o, const bf16* p, int lane) {
#pragma unroll
    for (int j = 0; j < 4; ++j) { const u32x2 w = *(const u32x2*)(p + 256 * j + 4 * lane); o.q[j].x = w.x; o.q[j].y = w.y; } }
__device__ __forceinline__ Row cvt_row(const RawB& i) { Row r;
#pragma unroll
    for (int j = 0; j < 4; ++j) r.v[j] = (f32x4){bflo(i.w[j].x), bfhi(i.w[j].x), bflo(i.w[j].y), bfhi(i.w[j].y)};
    return r; }
__device__ __forceinline__ Row cvt_row_f32(const RawF& i) { Row r;
#pragma unroll
    for (int j = 0; j < 4; ++j) r.v[j] = __builtin_bit_cast(f32x4, i.q[j]);
    return r; }
__device__ __forceinline__ Row cvt_row_bf16(const RawF& i) { Row r;
#pragma unroll
    for (int j = 0; j < 4; ++j) r.v[j] = (f32x4){bflo(i.q[j].x), bfhi(i.q[j].x), bflo(i.q[j].y), bfhi(i.q[j].y)};
    return r; }
#define ROWS3(LOAD, PROC, rb_, re_) do { int r = (rb_); const int rend_ = (re_), rl_ = rend_ - 1; LOAD(A, r); LOAD(B, (r + 1 < rl_ ? r + 1 : rl_)); \
        for (;;) { \
            LOAD(C, (r + 2 < rl_ ? r + 2 : rl_)); PROC(A, r); if (++r >= rend_) break; \
            LOAD(A, (r + 2 < rl_ ? r + 2 : rl_)); PROC(B, r); if (++r >= rend_) break; \
            LOAD(B, (r + 2 < rl_ ? r + 2 : rl_)); PROC(C, r); if (++r >= rend_) break; } } while (0)
__device__ __forceinline__ Row row_mul(const Row& a, const Row& b) { Row r;
#pragma unroll
    for (int j = 0; j < 4; ++j) r.v[j] = a.v[j] * b.v[j];
    return r; }
__device__ __forceinline__ Row row_mul1p(const Row& a, const Row& b) { Row r;
#pragma unroll
    for (int j = 0; j < 4; ++j) r.v[j] = a.v[j] * (1.0f + b.v[j]);
    return r; }
#define ROW_SEGMENTS(...) for (int rb = r_begin; rb < r_end; ) { const int bb = row_bb(rb); const int re0_ = bb < 16 ? (bb + 1) * 4096 : MT; const int re = re0_ < r_end ? re0_ : r_end; __VA_ARGS__; rb = re; }

__device__ __forceinline__ void transpose_item(const float* W, int K, int N, bf16* WT, int drow0, int k0, int n0, LAS float* scr, int lane) {
    float ld_[32];
#pragma unroll
    for (int i = 0; i < 32; ++i) ld_[i] = W[(size_t)(k0 + 2 * i + (lane >> 5)) * N + n0 + (lane & 31)];
#pragma unroll
    for (int i = 0; i < 32; ++i) scr[(2 * i + (lane >> 5)) * 33 + (lane & 31)] = ld_[i];
    LDS_WAIT(); asm volatile("" ::: "memory");
    const int c = lane & 7;
#pragma unroll
    for (int j = 0; j < 4; ++j) { const int n = (lane >> 3) + 8 * j; const LAS float* s = scr + (8 * c) * 33 + n;
        u32x4 o; o.x = pk2(s[0 * 33], s[1 * 33]); o.y = pk2(s[2 * 33], s[3 * 33]); o.z = pk2(s[4 * 33], s[5 * 33]); o.w = pk2(s[6 * 33], s[7 * 33]);
        *(u32x4*)(WT + (size_t)(drow0 + n) * K + k0 + 8 * c) = o; }
    LDS_WAIT(); asm volatile("" ::: "memory");
}
__device__ __forceinline__ unsigned pk4_fp8(float a, float b, float c, float d) { return pg8::pk4_fp8(a, b, c, d); }
__device__ __forceinline__ void transpose_item8(const float* W, int K, int N, unsigned char* WT, int drow0, int k0, int n0, float scale, LAS float* scr, int lane) {
    float ld_[32];
#pragma unroll
    for (int i = 0; i < 32; ++i) ld_[i] = W[(size_t)(k0 + 2 * i + (lane >> 5)) * N + n0 + (lane & 31)];
#pragma unroll
    for (int i = 0; i < 32; ++i) scr[(2 * i + (lane >> 5)) * 33 + (lane & 31)] = ld_[i];
    LDS_WAIT(); asm volatile("" ::: "memory");
    const int c = lane & 3;
#pragma unroll
    for (int j = 0; j < 2; ++j) { const int n = (lane >> 2) + 16 * j; const LAS float* sp = scr + (16 * c) * 33 + n;
        u32x4 o;
        o.x = pk4_fp8(sp[0 * 33] * scale, sp[1 * 33] * scale, sp[2 * 33] * scale, sp[3 * 33] * scale);
        o.y = pk4_fp8(sp[4 * 33] * scale, sp[5 * 33] * scale, sp[6 * 33] * scale, sp[7 * 33] * scale);
        o.z = pk4_fp8(sp[8 * 33] * scale, sp[9 * 33] * scale, sp[10 * 33] * scale, sp[11 * 33] * scale);
        o.w = pk4_fp8(sp[12 * 33] * scale, sp[13 * 33] * scale, sp[14 * 33] * scale, sp[15 * 33] * scale);
        *(u32x4*)(WT + (size_t)(drow0 + n) * K + k0 + 16 * c) = o; }
    LDS_WAIT(); asm volatile("" ::: "memory");
}
__device__ __forceinline__ void quant_strip_i8(const float* W, int K, int N, unsigned char* WT, float* SB, int drow0, int n0, LAS float* scr, int lane) {
    const float* wc = W + n0 + (lane & 31);
    float mx = 0.f;
    for (int k0 = 0; k0 < K; k0 += 64) {
        float ld_[32];
#pragma unroll
        for (int i = 0; i < 32; ++i) ld_[i] = wc[(size_t)(k0 + 2 * i + (lane >> 5)) * N];
#pragma unroll
        for (int i = 0; i < 32; ++i) mx = fmaxf(mx, fabsf(ld_[i]));
    }
    mx = fmaxf(mx, __shfl_xor(mx, 32));
    const float inv = mx > 0.f ? 127.0f / mx : 0.f;
    if (lane < 32) SB[drow0 + lane] = mx > 0.f ? mx * (1.0f / 127.0f) : 1.0f;
    for (int k0 = 0; k0 < K; k0 += 64) {
        float ld_[32];
#pragma unroll
        for (int i = 0; i < 32; ++i) ld_[i] = wc[(size_t)(k0 + 2 * i + (lane >> 5)) * N];
#pragma unroll
        for (int i = 0; i < 32; ++i) scr[(2 * i + (lane >> 5)) * 33 + (lane & 31)] = __builtin_rintf(ld_[i] * inv);
        LDS_WAIT(); asm volatile("" ::: "memory");
        const int c = lane & 3;
#pragma unroll
        for (int j = 0; j < 2; ++j) { const int n = (lane >> 2) + 16 * j; const LAS float* sp = scr + (16 * c) * 33 + n;
            unsigned o[4];
#pragma unroll
            for (int w = 0; w < 4; ++w) o[w] = ((unsigned)(int)sp[(4 * w) * 33] & 255u) | (((unsigned)(int)sp[(4 * w + 1) * 33] & 255u) << 8) | (((unsigned)(int)sp[(4 * w + 2) * 33] & 255u) << 16) | (((unsigned)(int)sp[(4 * w + 3) * 33] & 255u) << 24);
            *(u32x4*)(WT + (size_t)(drow0 + n) * K + k0 + 16 * c) = (u32x4){o[0], o[1], o[2], o[3]}; }
        LDS_WAIT(); asm volatile("" ::: "memory");
    }
}
__device__ __forceinline__ void colmax_item(const float* W, int N, unsigned* CMAX, int drow0, int k0, int n0, int lane) {
    float mx = 0.f;
#pragma unroll
    for (int i = 0; i < 32; ++i) mx = fmaxf(mx, fabsf(W[(size_t)(k0 + 2 * i + (lane >> 5)) * N + n0 + (lane & 31)]));
    mx = fmaxf(mx, __shfl_xor(mx, 32));
    if (lane < 32) atomicMax(CMAX + drow0 + lane, __builtin_bit_cast(unsigned, mx));
}
__device__ __forceinline__ void quant_item_i8(const float* W, int K, int N, unsigned char* WT, float* SB, const unsigned* CMAX, int drow0, int k0, int n0, LAS float* scr, int lane) {
    const float mx = __builtin_bit_cast(float, __hip_atomic_load(CMAX + drow0 + (lane & 31), __ATOMIC_RELAXED, __HIP_MEMORY_SCOPE_AGENT));
    const float inv = mx > 0.f ? 127.0f / mx : 0.f;
    if (k0 == 0 && lane < 32) SB[drow0 + lane] = mx > 0.f ? mx * (1.0f / 127.0f) : 1.0f;
    float ld_[32];
#pragma unroll
    for (int i = 0; i < 32; ++i) ld_[i] = W[(size_t)(k0 + 2 * i + (lane >> 5)) * N + n0 + (lane & 31)];
#pragma unroll
    for (int i = 0; i < 32; ++i) scr[(2 * i + (lane >> 5)) * 33 + (lane & 31)] = __builtin_rintf(ld_[i] * inv);
    LDS_WAIT(); asm volatile("" ::: "memory");
    const int c = lane & 3;
#pragma unroll
    for (int j = 0; j < 2; ++j) { const int n = (lane >> 2) + 16 * j; const LAS float* sp = scr + (16 * c) * 33 + n;
        unsigned o[4];
#pragma unroll
        for (int w = 0; w < 4; ++w) o[w] = ((unsigned)(int)sp[(4 * w) * 33] & 255u) | (((unsigned)(int)sp[(4 * w + 1) * 33] & 255u) << 8) | (((unsigned)(int)sp[(4 * w + 2) * 33] & 255u) << 16) | (((unsigned)(int)sp[(4 * w + 3) * 33] & 255u) << 24);
        *(u32x4*)(WT + (size_t)(drow0 + n) * K + k0 + 16 * c) = (u32x4){o[0], o[1], o[2], o[3]}; }
    LDS_WAIT(); asm volatile("" ::: "memory");
}
__device__ __forceinline__ int win_drow(int n0) {
    if (n0 < 1536) return n0;
    if (n0 < 1568) return 3072 + (n0 - 1536);
    if (n0 < 2080) return 1536 + (n0 - 1568);
    if (n0 < 2592) { const int j = n0 - 2080; return 2048 + (j >> 7) * 256 + (j & 127); }
    { const int j = n0 - 2592; return 2048 + (j >> 7) * 256 + 128 + (j & 127); }
}
__device__ __forceinline__ int pair_drow(int n0, int second) { return (n0 >> 7) * 256 + second * 128 + (n0 & 127); }

__device__ __forceinline__ void p0_prologue(const CAS DArgs& a, LAS unsigned char* lds) {
    PHASE_IDS();
    unsigned char* ws = AWS;
    {
        LAS float* sc = (LAS float*)lds;
        LAS float* part = (LAS float*)(lds + 17 * 1024 * 4);
        const float* c = AIN(1); const float* cc = AIN(3);
        bool filled = false;
        for (int t = vcu; t < 192; t += G) {
            if (!filled) {
                for (int i = tid; i < 17 * 1024; i += NTHR) { const float v = (i < 16 * 1024) ? c[i] : cc[i - 16 * 1024]; sc[i] = v / (1.0f + __expf(-v)); }
                __syncthreads(); filled = true;
            }
            const int l = t / 96, cb = t % 96, col = cb * 64 + lane;
            const float* wm = AIN(4) + (size_t)l * D * 6144 + col;
            float acc[17];
#pragma unroll
            for (int b = 0; b < 17; ++b) acc[b] = 0.f;
            for (int k = wave * 128; k < wave * 128 + 128; k += 4) {
                float w[4];
#pragma unroll
                for (int q = 0; q < 4; ++q) w[q] = wm[(size_t)(k + q) * 6144];
#pragma unroll
                for (int q = 0; q < 4; ++q)
#pragma unroll
                    for (int b = 0; b < 17; ++b) acc[b] += sc[b * 1024 + k + q] * w[q];
            }
#pragma unroll
            for (int b = 0; b < 17; ++b) part[(wave * 17 + b) * 64 + lane] = acc[b];
            __syncthreads();
            for (int i = tid; i < 17 * 64; i += NTHR) { const int b = i / 64, cl = i % 64; float s = AIN(5)[(size_t)l * 6144 + cb * 64 + cl];
#pragma unroll
                for (int w = 0; w < 8; ++w) s += part[(w * 17 + b) * 64 + cl];
                const int j = cb * 64 + cl;
                ((float*)(ws + WS_MOD))[((size_t)(l * 17 + b) * 6 + (j >> 10)) * D + (j & 1023)] = s; }
            __syncthreads();
        }
        __syncthreads();
    }
    LAS float* scr = (LAS float*)(lds + wave * 16384);
    for (int it = gw; it < 2 * 16 * 88; it += NGW) { const int sec = it / (16 * 88), r = it % (16 * 88), kb = r / 88, nb = r % 88;
        colmax_item(sec ? AIN(17) : AIN(16), DFF, (unsigned*)(ws + WS_CTL) + CW_CMAX13, pair_drow(nb * 32, sec), kb * 64, nb * 32, lane); }
    constexpr int I_IN = 16 * 97, I_OUT = 16 * 32, I_W2 = 44 * 32;
    constexpr int T0 = 2 * I_IN, T1 = T0 + 2 * I_OUT, T3 = T1 + I_W2;
    for (int it = gw; it < T3; it += NGW) {
        if (it < T0) { const int l = it / I_IN, r = it % I_IN, kb = r / 97, nb = r % 97;
            colmax_item(AIN(8) + (size_t)l * D * NPROJ_SRC, NPROJ_SRC, (unsigned*)(ws + WS_CTL) + CW_CMAXIN + l * NPROJ, win_drow(nb * 32), kb * 64, nb * 32, lane); }
        else if (it < T1) { const int q = it - T0, l = q / I_OUT, r = q % I_OUT, kb = r / 32, nb = r % 32;
            transpose_item(AIN(13) + (size_t)l * D * D, D, D, (bf16*)(ws + WS_WOUT) + (size_t)l * D * D, nb * 32, kb * 64, nb * 32, scr, lane); }
        else { const int r = it - T1, kb = r / 32, nb = r % 32;
            transpose_item8(AIN(18), DFF, D, ws + WS_W2, nb * 32, kb * 64, nb * 32, W2_SCALE, scr, lane); }
    }
    for (int i = gw * 64 + lane; i < 2 * 224 * 64; i += NGW * 64) { const int l = i / (224 * 64), r = i % (224 * 64);
        *(u32x4*)(ws + WS_WIN + (size_t)l * NPROJ * D + (size_t)3104 * D + (size_t)r * 16) = (u32x4){0u, 0u, 0u, 0u}; }
    for (int i = gw * 64 + lane; i < 2 * 224; i += NGW * 64) ((float*)(ws + WS_SBIN))[(i / 224) * NPROJ + 3104 + i % 224] = 1.0f;
}
__device__ __forceinline__ void convert_expert_weights(const CAS DArgs& a, LAS unsigned char* lds, int rank, int nranks, int part  ) {
    const int tid = fresh_tid(), lane = tid & 63, wave = __builtin_amdgcn_readfirstlane(tid >> 6);
    unsigned char* ws = AWS; LAS float* scr = (LAS float*)(lds + wave * 16384);
    constexpr int I_E1 = 16 * 112, I_E2 = 56 * 32, T4 = 16 * I_E1, T5 = T4 + 8 * I_E2;
    for (int it = (part ? T4 : 0) + rank; it < (part ? T5 : T4); it += nranks) {
        if (it < T4) { const int es = it / I_E1, e = es >> 1, s = es & 1, r = it % I_E1, kb = r / 112, nb = r % 112;
            transpose_item8((s ? AIN(21) : AIN(20)) + (size_t)e * D * DFFE, D, DFFE, ws + WS_E13 + (size_t)e * 2 * DFFE * D, pair_drow(nb * 32, s), kb * 64, nb * 32, W13_SCALE, scr, lane); }
        else { const int q = it - T4, e = q / I_E2, r = q % I_E2, kb = r / 32, nb = r % 32;
            transpose_item8(AIN(22) + (size_t)e * DFFE * D, DFFE, D, ws + WS_E2 + (size_t)e * D * DFFE, nb * 32, kb * 64, nb * 32, W2_SCALE, scr, lane); }
    }
}
#define ROW_BLOCK(nrows) const int RPW_ = ((nrows) + NGW - 1) / NGW; const int r_begin = gw * RPW_; const int r_end = (r_begin + RPW_ < (nrows)) ? r_begin + RPW_ : (nrows);
__device__ __forceinline__ int row_owner_wg(int r, int nrows, int NGW) { const int rpw = (nrows + NGW - 1) / NGW; return (r / rpw) / NWAVES; }

__device__ __forceinline__ void quantize_weights(const CAS DArgs& a, LAS unsigned char* lds) {
    PHASE_IDS();
    unsigned char* ws = AWS; LAS float* scr = (LAS float*)(lds + wave * 16384);
    for (int it = gw; it < 2 * 16 * 88; it += NGW) { const int sec = it / (16 * 88), r = it % (16 * 88), kb = r / 88, nb = r % 88;
        quant_item_i8(sec ? AIN(17) : AIN(16), D, DFF, ws + WS_W13, (float*)(ws + WS_SB13), (const unsigned*)(ws + WS_CTL) + CW_CMAX13, pair_drow(nb * 32, sec), kb * 64, nb * 32, scr, lane); }
    for (int it = gw; it < 2 * 16 * 97; it += NGW) { const int l = it / (16 * 97), r = it % (16 * 97), kb = r / 97, nb = r % 97;
        quant_item_i8(AIN(8) + (size_t)l * D * NPROJ_SRC, D, NPROJ_SRC, ws + WS_WIN + (size_t)l * NPROJ * D, (float*)(ws + WS_SBIN) + l * NPROJ, (const unsigned*)(ws + WS_CTL) + CW_CMAXIN + l * NPROJ, win_drow(nb * 32), kb * 64, nb * 32, scr, lane); }
}
__device__ __forceinline__ void phase_normmod0(const CAS DArgs& a) {
    const int tid = fresh_tid(), lane = tid & 63, wave = __builtin_amdgcn_readfirstlane(tid >> 6); const int G = gridDim.x, wg = blockIdx.x;
    const int gw = wg * NWAVES + wave, NGW = G * NWAVES;
    const float* MOD = (const float*)(AWS + WS_MOD); bf16* H = (bf16*)(AWS + WS_H);
    ROW_BLOCK(MT);
    if (r_begin >= r_end) return;
    const Row g = ld_row_f32(AIN(6), lane);
#define SRC0(r) ((r) < ML ? AIN(0) + (size_t)(r) * D : AIN(2) + (size_t)((r) - ML) * D)
    RawF xA, xB, xC;
#define NM_LOAD(S, rr) do { const int r_ = (rr); ldraw_f32(x##S, SRC0(r_), lane); } while (0)
#define NM_PROC(S, rr) do { const int r_ = (rr); Row x = cvt_row_f32(x##S); \
        const float rs = row_rstd(x); \
        _Pragma("unroll") for (int j = 0; j < 4; ++j) x.v[j] = (x.v[j] * rs) * gs.v[j] + sh.v[j]; \
        st_row_i8((unsigned char*)H + (size_t)r_ * D, (float*)(AWS + WS_SA) + r_, lane, x); \
    } while (0)
    ROW_SEGMENTS({ const Row gs = row_mul1p(g, ld_row_f32(modp(MOD, 0, bb, 1), lane)), sh = ld_row_f32(modp(MOD, 0, bb, 0), lane); ROWS3(NM_LOAD, NM_PROC, rb, re); });
#undef NM_LOAD
#undef NM_PROC
}
__device__ __forceinline__ void postmix_route(const CAS DArgs& a, const Row& x, int r, int lane, LAS float* wr_l, LAS unsigned* lcnt) {
    f32x4 la = (f32x4){0.f, 0.f, 0.f, 0.f}, lb = (f32x4){0.f, 0.f, 0.f, 0.f};
#pragma unroll
    for (int j = 0; j < 4; ++j)
#pragma unroll
        for (int q = 0; q < 4; ++q) { const LAS f32x4* wp = (const LAS f32x4*)(wr_l + (256 * j + 4 * lane + q) * 8); const float xv = x.v[j][q]; la += wp[0] * xv; lb += wp[1] * xv; }
    float lg[8];
#pragma unroll
    for (int e = 0; e < 4; ++e) { lg[e] = la[e]; lg[4 + e] = lb[e]; }
#define RT_STEP(CTRL, RM) _Pragma("unroll") for (int e = 0; e < 8; ++e) lg[e] += dpp0f<CTRL, RM>(lg[e]);
    RT_STEP(0x111, 0xf) RT_STEP(0x112, 0xf) RT_STEP(0x114, 0xf) RT_STEP(0x118, 0xf) RT_STEP(0x142, 0xa) RT_STEP(0x143, 0xc)
#undef RT_STEP
#pragma unroll
    for (int e = 0; e < 8; ++e) lg[e] = __builtin_bit_cast(float, __builtin_amdgcn_readlane(__builtin_bit_cast(int, lg[e]), 63));
    int e0 = 0; float v0 = lg[0];
#pragma unroll
    for (int e = 1; e < 8; ++e) if (lg[e] > v0) { v0 = lg[e]; e0 = e; }
    int e1 = -1; float v1 = -3.0e38f;
#pragma unroll
    for (int e = 0; e < 8; ++e) if (e != e0 && lg[e] > v1) { v1 = lg[e]; e1 = e; }
    if (lane == 0) {
        const float w1 = __builtin_amdgcn_rcpf(1.0f + __builtin_amdgcn_exp2f((v0 - v1) * 1.44269504f)), w0 = 1.0f - w1;
        const unsigned r0 = __hip_atomic_fetch_add(lcnt + e0, 1u, __ATOMIC_RELAXED, __HIP_MEMORY_SCOPE_WORKGROUP), r1 = __hip_atomic_fetch_add(lcnt + e1, 1u, __ATOMIC_RELAXED, __HIP_MEMORY_SCOPE_WORKGROUP);
        unsigned char* tk = AWS + WS_TOK;
        ((unsigned*)(tk + TOK_E))[r] = (unsigned)e0 | ((unsigned)e1 << 8);
        ((float*)(tk + TOK_W))[2 * r] = w0; ((float*)(tk + TOK_W))[2 * r + 1] = w1;
        ((unsigned*)(tk + TOK_RANK))[2 * r] = r0; ((unsigned*)(tk + TOK_RANK))[2 * r + 1] = r1;
    }
}
template <int l> __device__ __forceinline__ void phase_postmix(const CAS DArgs& a, LAS unsigned char* lds) {
    const int tid = fresh_tid(), lane = tid & 63, wave = __builtin_amdgcn_readfirstlane(tid >> 6); const int G = gridDim.x, wg = blockIdx.x;
    const float* MOD = (const float*)(AWS + WS_MOD); bf16* H = (bf16*)(AWS + WS_H); const bf16* Y = (const bf16*)(AWS + WS_P);
    float* XC = (float*)(AWS + WS_XC);
    constexpr int nrows = l == 0 ? MT : ML;
    const int gw = wg * NWAVES + wave, NGW = G * NWAVES;
    LAS float* wr_l = (LAS float*)lds;
    LAS unsigned* lcnt = (LAS unsigned*)(lds + LDSCTL_OFF + 64);
    if (l == 1) {
        for (int i = tid; i < D * NEXP; i += NTHR) wr_l[i] = AIN(19)[i];
        if (tid < 8) lcnt[tid] = 0u;
        __syncthreads();
    }
    ROW_BLOCK(nrows);
    if (r_begin < r_end) {
    const Row gpo = ld_row_f32(AIN(7) + (size_t)l * D, lane), gpr = ld_row_f32(AIN(14) + (size_t)l * D, lane);
    RawB yA, yB, yC; RawF xA, xB, xC;
#define PM_LOAD(S, rr) do { const int r_ = (rr); ldraw_bf16(y##S, Y + (size_t)r_ * D, lane); if constexpr (l == 0) ldraw_f32(x##S, SRC0(r_), lane); else ldraw_bf16(x##S, XR(r_), lane); } while (0)
#define PM_PROC(S, rr, LAT) do { const int r_ = (rr); const Row y = cvt_row(y##S); Row x; if constexpr (l == 0) x = cvt_row_f32(x##S); else x = cvt_row_bf16(x##S); \
        const float rs = row_rstd(y); \
        _Pragma("unroll") for (int j = 0; j < 4; ++j) x.v[j] = x.v[j] + gg.v[j] * (y.v[j] * rs); \
        if (LAT) st_row_bf16(XR(r_), lane, x); else st_row_f32(XC + (size_t)(r_ - ML) * D, lane, x); \
        const float rs2 = row_rstd(x); \
        _Pragma("unroll") for (int j = 0; j < 4; ++j) x.v[j] = (x.v[j] * rs2) * gs.v[j] + sh.v[j]; \
        if constexpr (l == 0) st_row_i8((unsigned char*)H + (size_t)r_ * D, (float*)(AWS + WS_SA) + r_, lane, x); else st_row_fp8((unsigned char*)H + (size_t)r_ * D, lane, x); \
        if constexpr (l == 1) postmix_route(a, x, r_, lane, wr_l, lcnt); \
    } while (0)
#define PM_PROC_L(S, rr) PM_PROC(S, rr, 1)
#define PM_PROC_C(S, rr) PM_PROC(S, rr, 0)
    ROW_SEGMENTS({ const Row gg = row_mul(ld_row_f32(modp(MOD, l, bb, 2), lane), gpo), gs = row_mul1p(gpr, ld_row_f32(modp(MOD, l, bb, 4), lane)), sh = ld_row_f32(modp(MOD, l, bb, 3), lane);
        if (bb < 16) ROWS3(PM_LOAD, PM_PROC_L, rb, re); else ROWS3(PM_LOAD, PM_PROC_C, rb, re); });
#undef PM_PROC_L
#undef PM_PROC_C
#undef PM_LOAD
#undef PM_PROC
    }
    if (l == 1) {
        __syncthreads();
        if (tid < 8) { const unsigned n = lcnt[tid];
            const unsigned base = __hip_atomic_fetch_add((unsigned*)(AWS + WS_CTL) + CW_ECNT + tid, n, __ATOMIC_RELAXED, __HIP_MEMORY_SCOPE_AGENT);
            ((unsigned*)(AWS + WS_TOK + TOK_WGBASE))[wg * 8 + tid] = base; }
        __syncthreads();
    }
}
__device__ __forceinline__ void phase_postffn0(const CAS DArgs& a) {
    const int tid = fresh_tid(), lane = tid & 63, wave = __builtin_amdgcn_readfirstlane(tid >> 6); const int G = gridDim.x, wg = blockIdx.x;
    const int gw = wg * NWAVES + wave, NGW = G * NWAVES;
    const float* MOD = (const float*)(AWS + WS_MOD); bf16* H = (bf16*)(AWS + WS_H); float* XC = (float*)(AWS + WS_XC);
    ROW_BLOCK(MT);
    if (r_begin >= r_end) return;
    const Row gpo = ld_row_f32(AIN(15), lane), gpr = ld_row_f32(AIN(6) + D, lane);
    RawB yA, yB, yC; RawF xA, xB, xC;
#define PF_LOAD(S, rr, LAT) do { const int r_ = (rr); ldraw_bf16(y##S, H + (size_t)r_ * D, lane); if (LAT) ldraw_bf16(x##S, XR(r_), lane); else ldraw_f32(x##S, XC + (size_t)(r_ - ML) * D, lane); } while (0)
#define PF_PROC(S, rr, LAT) do { const int r_ = (rr); const Row y = cvt_row(y##S); Row x = (LAT) ? cvt_row_bf16(x##S) : cvt_row_f32(x##S); \
        const float rs = row_rstd(y); \
        _Pragma("unroll") for (int j = 0; j < 4; ++j) x.v[j] = x.v[j] + gg.v[j] * (y.v[j] * rs); \
        if (LAT) st_row_bf16(XR(r_), lane, x); else st_row_f32(XC + (size_t)(r_ - ML) * D, lane, x); \
        const float rs2 = row_rstd(x); \
        _Pragma("unroll") for (int j = 0; j < 4; ++j) x.v[j] = (x.v[j] * rs2) * gs.v[j] + sh.v[j]; \
        st_row_i8(AWS + WS_US + (size_t)r_ * D, (float*)(AWS + WS_SA) + r_, lane, x);        \
    } while (0)
#define PF_LOAD_L(S, rr) PF_LOAD(S, rr, 1)
#define PF_PROC_L(S, rr) PF_PROC(S, rr, 1)
#define PF_LOAD_C(S, rr) PF_LOAD(S, rr, 0)
#define PF_PROC_C(S, rr) PF_PROC(S, rr, 0)
    ROW_SEGMENTS({ const Row gg = row_mul(ld_row_f32(modp(MOD, 0, bb, 5), lane), gpo), gs = row_mul1p(gpr, ld_row_f32(modp(MOD, 1, bb, 1), lane)), sh = ld_row_f32(modp(MOD, 1, bb, 0), lane);
        if (bb < 16) ROWS3(PF_LOAD_L, PF_PROC_L, rb, re); else ROWS3(PF_LOAD_C, PF_PROC_C, rb, re); });
#undef PF_LOAD_L
#undef PF_PROC_L
#undef PF_LOAD_C
#undef PF_PROC_C
#undef PF_LOAD
#undef PF_PROC
}
__device__ __forceinline__ void phase_final(const CAS DArgs& a) {
    const int tid = fresh_tid(), lane = tid & 63, wave = __builtin_amdgcn_readfirstlane(tid >> 6); const int G = gridDim.x, wg = blockIdx.x;
    const int gw = wg * NWAVES + wave, NGW = G * NWAVES;
    const float* MOD = (const float*)(AWS + WS_MOD); const unsigned char* YS = AWS + WS_YSLOT;
    const unsigned char* tk = AWS + WS_TOK;
    const int RPW_ = (ML + NGW - 1) / NGW; const int blk_begin = gw * RPW_; const int blk_end = (blk_begin + RPW_ < ML) ? blk_begin + RPW_ : ML;
    if (blk_begin >= blk_end) return;
    const Row g = ld_row_f32(AIN(15) + D, lane);
    for (int r_begin = blk_begin; r_begin < blk_end; r_begin += 64) { const int r_end = (r_begin + 64 < blk_end) ? r_begin + 64 : blk_end;
    const int nr = r_end - r_begin;
    u32x2 myslot = (u32x2){0u, 0u}; u32x2 mywt = (u32x2){0u, 0u};
    if (lane < nr) { myslot = ((const u32x2*)(tk + TOK_SLOT))[r_begin + lane]; mywt = ((const u32x2*)(tk + TOK_W))[r_begin + lane]; }
    struct Raw8 { unsigned w[4]; };
    Raw8 pA, pB, pC, qA, qB, qC; RawB xA, xB, xC;
#define FN_LOAD(S, rr) do { const int r_ = (rr), i_ = r_ - r_begin; \
        const unsigned s0_ = (unsigned)__builtin_amdgcn_readlane((int)myslot.x, i_), s1_ = (unsigned)__builtin_amdgcn_readlane((int)myslot.y, i_); \
        const unsigned char* p0_ = YS + (size_t)s0_ * D; const unsigned char* p1_ = YS + (size_t)s1_ * D; \
        _Pragma("unroll") for (int j = 0; j < 4; ++j) { p##S.w[j] = *(const unsigned*)(p0_ + 256 * j + 4 * lane); q##S.w[j] = *(const unsigned*)(p1_ + 256 * j + 4 * lane); } \
        ldraw_bf16(x##S, XR(r_), lane); } while (0)
#define FN_PROC(S, rr) do { const int r_ = (rr), i_ = r_ - r_begin; \
        const float w0 = __builtin_bit_cast(float, __builtin_amdgcn_readlane((int)mywt.x, i_)), w1 = __builtin_bit_cast(float, __builtin_amdgcn_readlane((int)mywt.y, i_)); \
        typedef float f32x2_ __attribute__((ext_vector_type(2))); \
        Row y; Row x = cvt_row(x##S); \
        _Pragma("unroll") for (int j = 0; j < 4; ++j) { \
            const f32x2_ a0 = __builtin_amdgcn_cvt_pk_f32_fp8((int)p##S.w[j], false), a1 = __builtin_amdgcn_cvt_pk_f32_fp8((int)p##S.w[j], true); \
            const f32x2_ b0 = __builtin_amdgcn_cvt_pk_f32_fp8((int)q##S.w[j], false), b1 = __builtin_amdgcn_cvt_pk_f32_fp8((int)q##S.w[j], true); \
            y.v[j] = (f32x4){a0.x * w0 + b0.x * w1, a0.y * w0 + b0.y * w1, a1.x * w0 + b1.x * w1, a1.y * w0 + b1.y * w1}; } \
        const float rs = row_rstd(y); \
        _Pragma("unroll") for (int j = 0; j < 4; ++j) x.v[j] = x.v[j] + gg.v[j] * (y.v[j] * rs); \
        st_row_f32(AOUT + (size_t)r_ * D, lane, x); \
    } while (0)
    ROW_SEGMENTS({ const Row gg = row_mul(ld_row_f32(modp(MOD, 1, bb, 5), lane), g); ROWS3(FN_LOAD, FN_PROC, rb, re); });
    }
#undef FN_LOAD
#undef FN_PROC
}
#undef SRC0
__device__ __forceinline__ void expert_offsets(const unsigned* ecnt, unsigned (&off)[9]) {
    off[0] = 0u;
#pragma unroll
    for (int e = 0; e < 8; ++e) off[e + 1] = off[e] + ((ecnt[e] + 255u) & ~255u);
}
__device__ __forceinline__ void phase_gather(const CAS DArgs& a) {
    const int tid = fresh_tid(), lane = tid & 63, wave = __builtin_amdgcn_readfirstlane(tid >> 6); const int G = gridDim.x, wg = blockIdx.x;
    const int gw = wg * NWAVES + wave, NGW = G * NWAVES;
    unsigned char* tk = AWS + WS_TOK; const unsigned* ecnt = (const unsigned*)(AWS + WS_CTL) + CW_ECNT;
    unsigned cnt[8], off[9];
#pragma unroll
    for (int e = 0; e < 8; ++e) cnt[e] = __hip_atomic_load(ecnt + e, __ATOMIC_RELAXED, __HIP_MEMORY_SCOPE_AGENT);
    expert_offsets(cnt, off);
    const unsigned char* H = AWS + WS_H; unsigned char* GA = AWS + WS_GATH;
    for (int rbase = gw; rbase < ML; rbase += NGW * 64) {
        const int nrw = (ML - rbase + NGW - 1) / NGW < 64 ? (ML - rbase + NGW - 1) / NGW : 64;
        unsigned s0 = 0u, s1 = 0u;
        if (lane < nrw) { const int r = rbase + lane * NGW;
            const int owner = row_owner_wg(r, ML, NGW);
            const unsigned ee = ((const unsigned*)(tk + TOK_E))[r]; const int e0 = ee & 255, e1 = (ee >> 8) & 255;
            const unsigned* wb = (const unsigned*)(tk + TOK_WGBASE) + owner * 8;
            unsigned o0 = 0, o1 = 0;
#pragma unroll
            for (int e = 0; e < 8; ++e) { o0 = (e == e0) ? off[e] : o0; o1 = (e == e1) ? off[e] : o1; }
            s0 = o0 + wb[e0] + ((const unsigned*)(tk + TOK_RANK))[2 * r]; s1 = o1 + wb[e1] + ((const unsigned*)(tk + TOK_RANK))[2 * r + 1];
            *(u32x2*)((unsigned*)(tk + TOK_SLOT) + 2 * r) = (u32x2){s0, s1}; }
        for (int i0 = 0; i0 < nrw; i0 += 8) {
            u32x4 v[8];
#pragma unroll
            for (int q = 0; q < 8; ++q) { const int i = (i0 + q < nrw) ? i0 + q : nrw - 1; v[q] = ((const u32x4*)(H + (size_t)(rbase + i * NGW) * D))[lane]; }
#pragma unroll
            for (int q = 0; q < 8; ++q) { if (i0 + q < nrw) { const unsigned a0 = (unsigned)__builtin_amdgcn_readlane((int)s0, i0 + q), a1 = (unsigned)__builtin_amdgcn_readlane((int)s1, i0 + q);
                ((u32x4*)(GA + (size_t)a0 * D))[lane] = v[q]; ((u32x4*)(GA + (size_t)a1 * D))[lane] = v[q]; } }
        }
    }
    for (int e = 0; e < 8; ++e) { const unsigned p0 = off[e] + cnt[e], p1 = off[e + 1];
        for (unsigned s = p0 + gw; s < p1; s += NGW) ((u32x4*)(GA + (size_t)s * D))[lane] = (u32x4){0u, 0u, 0u, 0u}; }
    if (wg == 0) { int* texp = (int*)(tk + TOK_TEXP);
        for (int t = tid; t < MAXTILE; t += NTHR) { int e = 0;
#pragma unroll
            for (int q = 1; q < 8; ++q) e = ((unsigned)(t * 256) >= off[q]) ? q : e;
            texp[t] = e; } }
}

constexpr int G1P = 72;
constexpr int G1_QT = 0, G1_KT = 18432, G1_KH = 36864, G1_VT = 55296, G1_AT = 73728, G1_WD = 82944, G1_BD = 91136;
template <int CTRL, int RM> __device__ __forceinline__ float dppf(float v) { return __builtin_bit_cast(float, __builtin_amdgcn_update_dpp(0, __builtin_bit_cast(int, v), CTRL, RM, 0xf, true)); }
__device__ __forceinline__ float wave_incl_scan(float v) {
    v += dppf<0x111, 0xf>(v); v += dppf<0x112, 0xf>(v); v += dppf<0x114, 0xf>(v); v += dppf<0x118, 0xf>(v);
    v += dppf<0x142, 0xa>(v); v += dppf<0x143, 0xc>(v); return v; }
__device__ __forceinline__ size_t us_slot(int chunk, int h, int dir) { return ((size_t)(chunk * 4 + h) * 2 + dir) * 8192; }
__device__ __forceinline__ float log_sigmoid(float z) { return fminf(z, 0.f) - __logf(1.0f + __expf(-fabsf(z))); }

__device__ __forceinline__ void phase_gla_local(const CAS DArgs& a, int l, LAS unsigned char* lds) {
    const int tid = fresh_tid(), lane = tid & 63, wave = __builtin_amdgcn_readfirstlane(tid >> 6); const int G = gridDim.x, wg = blockIdx.x;
    bf16* P = (bf16*)(AWS + WS_P); unsigned char* U8 = AWS + WS_U8; float* DC = (float*)(AWS + WS_DC);
    LAS bf16* QT = (LAS bf16*)(lds + G1_QT); LAS bf16* KT = (LAS bf16*)(lds + G1_KT); LAS bf16* KH = (LAS bf16*)(lds + G1_KH);
    LAS bf16* VT = (LAS bf16*)(lds + G1_VT); LAS bf16* AT = (LAS bf16*)(lds + G1_AT);
    LAS float* WD = (LAS float*)(lds + G1_WD); LAS float* BD = (LAS float*)(lds + G1_BD);
    const int fr = lane & 15, fq = lane >> 4;
    const int dir = wave >> 2, d0 = (wave & 3) * 16;
    u32x4 pa0, pa1, pq0, pq1, pk0, pk1, pv0, pv1;
#define G1_LOAD_AQK(uu) do { const int ch_ = (uu) >> 2, hh_ = (uu) & 3; const bf16* pr_ = P + (size_t)(ch_ * 64 + lane) * LDP; \
        pa0 = *(const u32x4*)(pr_ + PA + 16 * dir); pa1 = *(const u32x4*)(pr_ + PA + 16 * dir + 8); \
        pq0 = *(const u32x4*)(pr_ + PQ + 64 * hh_ + d0); pq1 = *(const u32x4*)(pr_ + PQ + 64 * hh_ + d0 + 8); \
        pk0 = *(const u32x4*)(pr_ + PK + 64 * hh_ + d0); pk1 = *(const u32x4*)(pr_ + PK + 64 * hh_ + d0 + 8); } while (0)
#define G1_LOAD_V(uu) do { const int ch_ = (uu) >> 2, hh_ = (uu) & 3; \
        const bf16* vr_ = P + (size_t)(ch_ * 64 + (tid >> 3)) * LDP + PV + 128 * hh_ + (tid & 7) * 16; pv0 = *(const u32x4*)vr_; pv1 = *(const u32x4*)(vr_ + 8); } while (0)
#define G1_LOAD(uu) do { G1_LOAD_AQK(uu); G1_LOAD_V(uu); } while (0)
    if (wg < NCHUNK * 4) G1_LOAD(wg);
    int hcur = -1;
    for (int u = wg; u < NCHUNK * 4; u += G) {
        const int chunk = u >> 2, h = u & 3;
        if (h != hcur) { hcur = h; const int dr = tid >> 8, d = (tid >> 2) & 63, r0 = (tid & 3) * 4;
          const float* wsrc = AIN(9) + ((size_t)(l * 2 + dr) * 16 + r0) * 256 + 64 * h + d;
          *(LAS f32x4*)(WD + (dr * 64 + d) * 16 + r0) = (f32x4){wsrc[0], wsrc[256], wsrc[512], wsrc[768]};
          if (tid < 128) BD[tid] = AIN(10)[(size_t)(l * 2 + (tid >> 6)) * 256 + 64 * h + (tid & 63)];
          __syncthreads(); }
        {
            bf16* prow = P + (size_t)(chunk * 64 + lane) * LDP;
            float av[16], qv[16], kv[16];
#pragma unroll
            for (int i = 0; i < 4; ++i) { av[2 * i] = bflo(pa0[i]); av[2 * i + 1] = bfhi(pa0[i]); av[8 + 2 * i] = bflo(pa1[i]); av[9 + 2 * i] = bfhi(pa1[i]);
                qv[2 * i] = bflo(pq0[i]); qv[2 * i + 1] = bfhi(pq0[i]); qv[8 + 2 * i] = bflo(pq1[i]); qv[9 + 2 * i] = bfhi(pq1[i]);
                kv[2 * i] = bflo(pk0[i]); kv[2 * i + 1] = bfhi(pk0[i]); kv[8 + 2 * i] = bflo(pk1[i]); kv[9 + 2 * i] = bfhi(pk1[i]); }
            if (u + G < NCHUNK * 4) G1_LOAD_AQK(u + G);
            unsigned qpk[8], kpk[8];
            float dtot = 0.f, qt_e = 0.f, kt_e = 0.f, kh_e = 0.f;
#pragma unroll
            for (int g4 = 0; g4 < 4; ++g4) {
                float la4[4], inc4[4];
#pragma unroll
                for (int q = 0; q < 4; ++q) { const int dd = 4 * g4 + q;
                    const LAS f32x4* wv = (const LAS f32x4*)(WD + (dir * 64 + d0 + dd) * 16);
                    const f32x4 w0 = wv[0], w1 = wv[1], w2 = wv[2], w3 = wv[3];
                    float z = BD[dir * 64 + d0 + dd];
#pragma unroll
                    for (int r = 0; r < 4; ++r) z += av[r] * w0[r] + av[4 + r] * w1[r] + av[8 + r] * w2[r] + av[12 + r] * w3[r];
                    la4[q] = (fminf(z, 0.f) * 1.44269504f - __builtin_amdgcn_logf(1.0f + __builtin_amdgcn_exp2f(-1.44269504f * fabsf(z)))) * (1.0f / 16.0f);
                    inc4[q] = la4[q]; }
#define G1_SCAN_STEP(CTRL, RM) _Pragma("unroll") for (int q = 0; q < 4; ++q) inc4[q] += dppf<CTRL, RM>(inc4[q]);
                G1_SCAN_STEP(0x111, 0xf) G1_SCAN_STEP(0x112, 0xf) G1_SCAN_STEP(0x114, 0xf) G1_SCAN_STEP(0x118, 0xf) G1_SCAN_STEP(0x142, 0xa) G1_SCAN_STEP(0x143, 0xc)
#undef G1_SCAN_STEP
#pragma unroll
                for (int q = 0; q < 4; ++q) { const int dd = 4 * g4 + q; const float la = la4[q], inc = inc4[q];
                    const float tot = __builtin_bit_cast(float, __builtin_amdgcn_readlane(__builtin_bit_cast(int, inc), 63));
                    const float bc = dir == 0 ? inc : (tot - inc + la);
                    const float etot = __builtin_amdgcn_exp2f(tot);
                    const float qt = qv[dd] * 0.125f * __builtin_amdgcn_exp2f(bc), kt = kv[dd] * __builtin_amdgcn_exp2f(-bc), kh = kt * etot;
                    if (dd & 1) { qpk[dd >> 1] = pk2(qt_e, qt); kpk[dd >> 1] = pk2(kt_e, kt); const unsigned khp = pk2(kh_e, kh);
                        KH[(dir * 64 + d0 + dd - 1) * G1P + lane] = (bf16)(khp & 0xffffu); KH[(dir * 64 + d0 + dd) * G1P + lane] = (bf16)(khp >> 16); }
                    else { qt_e = qt; kt_e = kt; kh_e = kh; }
                    dtot = (lane == dd) ? etot : dtot; }
            }
            *(LAS u32x4*)(QT + (dir * 64 + lane) * G1P + d0) = (u32x4){qpk[0], qpk[1], qpk[2], qpk[3]}; *(LAS u32x4*)(QT + (dir * 64 + lane) * G1P + d0 + 8) = (u32x4){qpk[4], qpk[5], qpk[6], qpk[7]};
            *(LAS u32x4*)(KT + (dir * 64 + lane) * G1P + d0) = (u32x4){kpk[0], kpk[1], kpk[2], kpk[3]}; *(LAS u32x4*)(KT + (dir * 64 + lane) * G1P + d0 + 8) = (u32x4){kpk[4], kpk[5], kpk[6], kpk[7]};
            if (lane < 16) DC[((size_t)(chunk * 4 + h) * 2 + dir) * 64 + d0 + lane] = dtot;
            { const int j = tid >> 3, eb = (tid & 7) * 16;
              const int js = (((j >> 3) ^ (tid & 7)) << 3) | (j & 7);
#pragma unroll
              for (int i = 0; i < 4; ++i) { VT[(eb + 2 * i) * G1P + js] = (bf16)(pv0[i] & 0xffffu); VT[(eb + 2 * i + 1) * G1P + js] = (bf16)(pv0[i] >> 16);
                  VT[(eb + 8 + 2 * i) * G1P + js] = (bf16)(pv1[i] & 0xffffu); VT[(eb + 9 + 2 * i) * G1P + js] = (bf16)(pv1[i] >> 16); } }
            LDS_BARRIER();
            if (u + G < NCHUNK * 4) G1_LOAD_V(u + G);
            bf16* qd = prow + (dir == 0 ? PQ : PK) + 64 * h + d0;
            *(u32x4*)qd = (u32x4){qpk[0], qpk[1], qpk[2], qpk[3]}; *(u32x4*)(qd + 8) = (u32x4){qpk[4], qpk[5], qpk[6], qpk[7]};
        }
#pragma unroll
        for (int t = 0; t < 2; ++t) {
            const int job = wave * 2 + t, jt = job >> 2, it = job & 3;
            f32x4 accf = (f32x4){0.f, 0.f, 0.f, 0.f}, accb = (f32x4){0.f, 0.f, 0.f, 0.f};
#pragma unroll
            for (int ks = 0; ks < 2; ++ks) {
                const bf16x8 ka = *(const LAS bf16x8*)(KT + (0 * 64 + 16 * jt + fr) * G1P + 32 * ks + 8 * fq), qa = *(const LAS bf16x8*)(QT + (0 * 64 + 16 * it + fr) * G1P + 32 * ks + 8 * fq);
                accf = __builtin_amdgcn_mfma_f32_16x16x32_bf16(ka, qa, accf, 0, 0, 0);
                const bf16x8 kb = *(const LAS bf16x8*)(KT + (1 * 64 + 16 * jt + fr) * G1P + 32 * ks + 8 * fq), qb = *(const LAS bf16x8*)(QT + (1 * 64 + 16 * it + fr) * G1P + 32 * ks + 8 * fq);
                accb = __builtin_amdgcn_mfma_f32_16x16x32_bf16(kb, qb, accb, 0, 0, 0);
            }
            const int i = 16 * it + fr, j0 = 16 * jt + 4 * fq;
            float s[4];
#pragma unroll
            for (int r = 0; r < 4; ++r) { const int j = j0 + r; s[r] = (j <= i ? accf[r] : 0.f) + (j >= i ? accb[r] : 0.f); }
            u32x2 w; w.x = pk2(s[0], s[1]); w.y = pk2(s[2], s[3]);
            *(LAS u32x2*)(AT + i * G1P + j0) = w;
        }
        LDS_BARRIER();
        {
            const int ew = wave & 3, ih = wave >> 2;
            bf16x8 vo[2][2];
#pragma unroll
            for (int j = 0; j < 2; ++j)
#pragma unroll
                for (int ks = 0; ks < 2; ++ks) vo[j][ks] = *(const LAS bf16x8*)(VT + (32 * ew + 8 * (fr >> 2) + 4 * j + (fr & 3)) * G1P + 8 * ((4 * ks + fq) ^ (2 * ew + (fr >> 3))));
#pragma unroll
            for (int t = 0; t < 2; ++t) { const int it = 2 * ih + t;
                f32x4 acc0 = (f32x4){0.f, 0.f, 0.f, 0.f}, acc1 = (f32x4){0.f, 0.f, 0.f, 0.f};
#pragma unroll
                for (int ks = 0; ks < 2; ++ks) { const bf16x8 af = *(const LAS bf16x8*)(AT + (16 * it + fr) * G1P + 32 * ks + 8 * fq);
                    acc0 = __builtin_amdgcn_mfma_f32_16x16x32_bf16(vo[0][ks], af, acc0, 0, 0, 0); acc1 = __builtin_amdgcn_mfma_f32_16x16x32_bf16(vo[1][ks], af, acc1, 0, 0, 0); }
                u32x4 w; w.x = pk2_sw(acc0[0], acc0[1]); w.y = pk2_sw(acc0[2], acc0[3]); w.z = pk2_sw(acc1[0], acc1[1]); w.w = pk2_sw(acc1[2], acc1[3]);
                *(u32x4*)(P + (size_t)(chunk * 64 + 16 * it + fr) * LDP + PV + 128 * h + 32 * ew + 8 * fq) = w;
            }
            const int et = wave;
            bf16x8 vf[2];
#pragma unroll
            for (int ks = 0; ks < 2; ++ks) vf[ks] = *(const LAS bf16x8*)(VT + (16 * et + fr) * G1P + 8 * ((4 * ks + fq) ^ et));
#pragma unroll
            for (int dr = 0; dr < 2; ++dr) {
                u32x4 wq;
#pragma unroll
                for (int dt = 0; dt < 4; ++dt) {
                    f32x4 acc = (f32x4){0.f, 0.f, 0.f, 0.f};
#pragma unroll
                    for (int ks = 0; ks < 2; ++ks) { const bf16x8 kf = *(const LAS bf16x8*)(KH + (dr * 64 + 16 * (fr >> 2) + 4 * dt + (fr & 3)) * G1P + 32 * ks + 8 * fq);
                        acc = __builtin_amdgcn_mfma_f32_16x16x32_bf16(kf, vf[ks], acc, 0, 0, 0); }
                    wq[dt] = pk4_fp8(acc[0], acc[1], acc[2], acc[3]);
                }
                *(u32x4*)(U8 + us_slot(chunk, h, dr) + (size_t)(16 * et + fr) * 64 + 16 * fq) = wq;
            }
        }
        LDS_BARRIER();
    }
}
#undef G1_LOAD
#undef G1_LOAD_AQK
#undef G1_LOAD_V
__device__ __forceinline__ void phase_conv(const CAS DArgs& a, int l) {
    const int tid = fresh_tid(); const int G = gridDim.x, wg = blockIdx.x;
    const bf16* P = (const bf16*)(AWS + WS_P); bf16* MIX = (bf16*)(AWS + WS_H);
    const float* cw = AIN(12) + (size_t)l * 3 * 512;
    const int nrows = l == 0 ? MT : ML;
    const int c8 = (tid & 63) * 8;
    float wl[3][8];
#pragma unroll
    for (int k = 0; k < 3; ++k) { const f32x4 wa = *(const f32x4*)(cw + 512 * k + c8), wb = *(const f32x4*)(cw + 512 * k + c8 + 4);
#pragma unroll
        for (int i = 0; i < 4; ++i) { wl[k][i] = wa[i]; wl[k][4 + i] = wb[i]; } }
    const int ngroups = nrows / 4;
    for (int g = wg * 8 + (tid >> 6); g < ngroups; g += G * 8) {
        const int r0 = g * 4;
        const int t0 = r0 < ML ? (r0 & 63) : ((r0 - ML) & 255); const int last = r0 < ML ? 63 : 255;
        const bf16* pr = P + (size_t)r0 * LDP;
        u32x4 u[6], bg[4];
        u[0] = (u32x4){0u, 0u, 0u, 0u}; u[5] = (u32x4){0u, 0u, 0u, 0u};
        if (t0 > 0) u[0] = *(const u32x4*)(pr - LDP + PU + c8);
#pragma unroll
        for (int i = 0; i < 4; ++i) { u[1 + i] = *(const u32x4*)(pr + (size_t)i * LDP + PU + c8); bg[i] = *(const u32x4*)(pr + (size_t)i * LDP + PB + c8); }
        if (t0 + 3 < last) u[5] = *(const u32x4*)(pr + (size_t)4 * LDP + PU + c8);
#pragma unroll
        for (int i = 0; i < 4; ++i) {
            float o[8];
#pragma unroll
            for (int q = 0; q < 4; ++q) {
                o[2 * q] = bflo(bg[i][q]) * (wl[0][2 * q] * bflo(u[i][q]) + wl[1][2 * q] * bflo(u[i + 1][q]) + wl[2][2 * q] * bflo(u[i + 2][q]));
                o[2 * q + 1] = bfhi(bg[i][q]) * (wl[0][2 * q + 1] * bfhi(u[i][q]) + wl[1][2 * q + 1] * bfhi(u[i + 1][q]) + wl[2][2 * q + 1] * bfhi(u[i + 2][q]));
            }
            *(u32x4*)(MIX + (size_t)(r0 + i) * D + 512 + c8) = (u32x4){pk2(o[0], o[1]), pk2(o[2], o[3]), pk2(o[4], o[5]), pk2(o[6], o[7])};
        }
    }
}
__device__ __forceinline__ void phase_gla_scan(const CAS DArgs& a) {
    const int tid = fresh_tid(); const int G = gridDim.x, wg = blockIdx.x;
    bf16* US = (bf16*)(AWS + WS_US); const unsigned char* U8 = AWS + WS_U8; const float* DC = (const float*)(AWS + WS_DC);
    for (int w = wg; w < NB * 4 * 2 * 2; w += G) {
        const int prob = w >> 1, g8 = (w & 1) * 512 + tid, dir = prob & 1, h = (prob >> 1) & 3, b = prob >> 3;
        const int dg = (g8 & 7) * 8;
#define SCAN_CHUNK(s) (((s) < 4) ? (ML / 64 + b * 4 + (dir == 0 ? (s) : 3 - (s))) : (b * 64 + (dir == 0 ? (s) - 4 : 67 - (s))))
        float S[8];
#pragma unroll
        for (int i = 0; i < 8; ++i) { S[i] = 0.f; asm volatile("" : "+v"(S[i])); }
        u32x2 uw[4]; f32x4 da[4], db[4];
#define SCAN_LOAD(k, s) do { const int c_ = SCAN_CHUNK(s); uw[k] = *(const u32x2*)(U8 + us_slot(c_, h, dir) + (size_t)g8 * 8); \
            const float* dc = DC + ((size_t)(c_ * 4 + h) * 2 + dir) * 64 + dg; da[k] = *(const f32x4*)dc; db[k] = *(const f32x4*)(dc + 4); } while (0)
#pragma unroll
        for (int k = 0; k < 4; ++k) SCAN_LOAD(k, k);
        for (int s0 = 0; s0 < 68; s0 += 4) {
#pragma unroll
            for (int k = 0; k < 4; ++k) {
                const int s = s0 + k; const int chunk = SCAN_CHUNK(s);
                typedef float f32x2_ __attribute__((ext_vector_type(2)));
                const u32x2 u = uw[k]; const f32x4 d0 = da[k], d1 = db[k];
                *(u32x4*)(US + us_slot(chunk, h, dir) + (size_t)g8 * 8) = (u32x4){pk2(S[0], S[1]), pk2(S[2], S[3]), pk2(S[4], S[5]), pk2(S[6], S[7])};
                const f32x2_ u01 = __builtin_amdgcn_cvt_pk_f32_fp8((int)u.x, false), u23 = __builtin_amdgcn_cvt_pk_f32_fp8((int)u.x, true), u45 = __builtin_amdgcn_cvt_pk_f32_fp8((int)u.y, false), u67 = __builtin_amdgcn_cvt_pk_f32_fp8((int)u.y, true);
                S[0] = d0[0] * S[0] + u01.x; S[1] = d0[1] * S[1] + u01.y; S[2] = d0[2] * S[2] + u23.x; S[3] = d0[3] * S[3] + u23.y;
                S[4] = d1[0] * S[4] + u45.x; S[5] = d1[1] * S[5] + u45.y; S[6] = d1[2] * S[6] + u67.x; S[7] = d1[3] * S[7] + u67.y;
                SCAN_LOAD(k, (s + 4 < 68 ? s + 4 : 67));
            }
        }
#undef SCAN_LOAD
#undef SCAN_CHUNK
    }
}
constexpr int G3_GN = 131072 + 2048;
__device__ __forceinline__ void phase_gla_out(const CAS DArgs& a, int l, LAS unsigned char* lds) {
    const int tid = fresh_tid(), lane = tid & 63, wave = __builtin_amdgcn_readfirstlane(tid >> 6); const int G = gridDim.x, wg = blockIdx.x;
    const bf16* P = (const bf16*)(AWS + WS_P); const unsigned char* USb = (const unsigned char*)(AWS + WS_US); bf16* MIX = (bf16*)(AWS + WS_H);
    const int fr = lane & 15, fq = lane >> 4, it = wave & 3, grp = wave >> 2;
    const int nunits = (l == 0 ? NCHUNK : ML / 64) * 4;
    if (tid < 128) *(LAS float*)(lds + G3_GN + 4 * tid) = (AIN(11) + (size_t)l * 128)[tid];
    unsigned srcoff[4];
#pragma unroll
    for (int i = 0; i < 4; ++i) { const int p = (4 * it + i) * 64 + lane, r = p >> 3, c = (p & 7) ^ ((r >> 1) & 7); srcoff[i] = (unsigned)(r * 128 + c * 16); }
    const int fo0 = fr * 128 + (((0 + fq) ^ (fr >> 1)) * 16), fo1 = fr * 128 + (((4 + fq) ^ (fr >> 1)) * 16);
    bf16x8 qfA[2][2], qfB[2][2]; u32x2 oiA[8], ggA[8], oiB[8], ggB[8];
#define G3_FETCH(uu, buf, QF, OI, GG) do { const int ch_ = (uu) >> 2, hh_ = (uu) & 3; \
        _Pragma("unroll") for (int dr = 0; dr < 2; ++dr) _Pragma("unroll") for (int i = 0; i < 4; ++i) \
            __builtin_amdgcn_global_load_lds((const unsigned*)(USb + us_slot(ch_, hh_, dr) * 2 + srcoff[i]), (LAS unsigned*)(lds + ((((buf) * 2 + grp) * 2 + dr) * 16384) + (4 * it + i) * 1024), 16, 0, 0); \
        const bf16* pr_ = P + (size_t)(ch_ * 64 + 16 * it + fr) * LDP; \
        _Pragma("unroll") for (int dr = 0; dr < 2; ++dr) _Pragma("unroll") for (int ks = 0; ks < 2; ++ks) QF[dr][ks] = *(const bf16x8*)(pr_ + (dr == 0 ? PQ : PK) + 64 * hh_ + 32 * ks + 8 * fq); \
        _Pragma("unroll") for (int et = 0; et < 8; ++et) { OI[et] = *(const u32x2*)(pr_ + PV + 128 * hh_ + 16 * et + 4 * fq); GG[et] = *(const u32x2*)(pr_ + PGT + 128 * hh_ + 16 * et + 4 * fq); } } while (0)
#define G3_UNIT(buf, QF, OI, GG, QFN, OIN, GGN) { \
        __builtin_amdgcn_s_waitcnt(0x0F78);                    \
        LDS_BARRIER();                                        \
        const int un = u + G * 2; const bool hn = un < nunits; \
        G3_FETCH((hn ? un : u), 1 - (buf), QFN, OIN, GGN);      \
        const int chunk = u >> 2, h = u & 3; \
        const int row = chunk * 64 + 16 * it + fr; \
        LAS const unsigned char* img = lds + ((buf) * 2 + grp) * 2 * 16384; \
        f32x4 acc[8]; float ss = 0.f; \
        _Pragma("unroll") for (int et = 0; et < 8; ++et) { \
            acc[et] = (f32x4){0.f, 0.f, 0.f, 0.f}; \
            _Pragma("unroll") for (int dr = 0; dr < 2; ++dr) { \
                const bf16x8 s0 = *(const LAS bf16x8*)(img + dr * 16384 + et * 2048 + fo0), s1 = *(const LAS bf16x8*)(img + dr * 16384 + et * 2048 + fo1); \
                acc[et] = __builtin_amdgcn_mfma_f32_16x16x32_bf16(s0, QF[dr][0], acc[et], 0, 0, 0); \
                acc[et] = __builtin_amdgcn_mfma_f32_16x16x32_bf16(s1, QF[dr][1], acc[et], 0, 0, 0); \
            } \
              \
            acc[et][0] += bflo(OI[et].x); acc[et][1] += bfhi(OI[et].x); acc[et][2] += bflo(OI[et].y); acc[et][3] += bfhi(OI[et].y); \
            ss += (acc[et][0] * acc[et][0] + acc[et][1] * acc[et][1]) + (acc[et][2] * acc[et][2] + acc[et][3] * acc[et][3]); \
        } \
        ss += __shfl_xor(ss, 16); ss += __shfl_xor(ss, 32); \
        const float rs = __builtin_amdgcn_rsqf(ss * (1.0f / 128.0f) + EPS); \
        _Pragma("unroll") for (int et = 0; et < 8; ++et) { \
            const int e = 16 * et + 4 * fq; \
            const f32x4 gv = *(const LAS f32x4*)(lds + G3_GN + 4 * e); \
            const float g0 = bflo(GG[et].x), g1 = bfhi(GG[et].x), g2 = bflo(GG[et].y), g3 = bfhi(GG[et].y); \
            const float o0 = acc[et][0] * rs * gv[0] * pg8::silu_f(g0), o1 = acc[et][1] * rs * gv[1] * pg8::silu_f(g1), o2 = acc[et][2] * rs * gv[2] * pg8::silu_f(g2), o3 = acc[et][3] * rs * gv[3] * pg8::silu_f(g3); \
            u32x2 w; w.x = pk2(o0, o1); w.y = pk2(o2, o3); \
            *(u32x2*)(MIX + (size_t)row * D + 128 * h + e) = w; \
        } \
        u = un; if (!hn) break; }
    int u = wg * 2 + grp;
    if (u < nunits) {
        G3_FETCH(u, 0, qfA, oiA, ggA);
        __builtin_amdgcn_s_waitcnt(0x0F70);
        for (;;) {
            G3_UNIT(0, qfA, oiA, ggA, qfB, oiB, ggB)
            G3_UNIT(1, qfB, oiB, ggB, qfA, oiA, ggA)
        }
    }
#undef G3_UNIT
#undef G3_FETCH
}

constexpr int NPHASE = 29;
__global__ void __launch_bounds__(NTHR, 2) mk_fwd(Args args) {
    extern __shared__ __attribute__((aligned(16))) unsigned char lds_raw[];
    LAS unsigned char* lds = (LAS unsigned char*)lds_raw;
    const int tid = threadIdx.x, lane = tid & 63, wave = __builtin_amdgcn_readfirstlane(tid >> 6);
    const int G = gridDim.x, wg = blockIdx.x;
    const int vcu = (G % 8 == 0) ? (wg % 8) * (G / 8) + wg / 8 : wg;
    const int gw = vcu * NWAVES + wave, NGW = G * NWAVES;
    const CAS DArgs* kap = (const CAS DArgs*)__builtin_amdgcn_kernarg_segment_ptr();
#define KA() (*({ const CAS DArgs* _p = kap; asm volatile("" : "+s"(_p)); _p; }))
    unsigned char* ws = args.ws;
    for (int u = tid; u < (LDS_BYTES - LDSCTL_OFF) / 4; u += NTHR) ((LAS unsigned*)(lds + LDSCTL_OFF))[u] = 0u;
    __syncthreads();
    XcdBarrier bar; bar.bar = (unsigned*)(ws + WS_CTL) + CW_BAR; bar.x = 0; bar.st = nullptr;
#if !MK_PER_PHASE
    bar = xcd_barrier_post((unsigned*)(ws + WS_CTL) + CW_BAR, (volatile LAS unsigned*)(lds + LDSCTL_OFF));
#endif
    const int lo = args.ph_lo, hi = args.ph_hi;
    unsigned long long probe_t0 = PROBE_MASK != 0u ? __builtin_amdgcn_s_memrealtime() : 0ull; (void)probe_t0;
#define IN(k) (lo <= (k) && (k) < hi)
#if MK_PER_PHASE
#define SEAM(k) do { } while (0)
#else
#define SEAM(k) do { if (PROBE_MASK != 0u) { if ((PROBE_MASK >> (k)) & 1u) { const unsigned long long t1_ = __builtin_amdgcn_s_memrealtime(); const unsigned long long te_ = t1_ + (t1_ - probe_t0); \
        while (__builtin_amdgcn_s_memrealtime() < te_) __builtin_amdgcn_s_sleep(8); } } \
    if (IN(k) && IN((k) + 1)) { XcdBarrier b2_ = bar; asm volatile("" : "+s"(b2_.bar)); xcd_barrier(b2_); } if (PROBE_MASK != 0u) probe_t0 = __builtin_amdgcn_s_memrealtime(); } while (0)
#endif
#define WSP ((unsigned char*)KA().ws)
#define Hb ((bf16*)(WSP + WS_H))
#define Pb ((bf16*)(WSP + WS_P))

    if (IN(0)) { p0_prologue(KA(), lds); } SEAM(0);
    if (IN(1)) { quantize_weights(KA(), lds); phase_normmod0(KA()); } SEAM(1);

    for (int l = 0; l < 2; ++l) {
        const int pb = 9 * l;
        if (IN(2 + pb)) {
            pg8::Gemm g{l == 0 ? WSP + WS_H : WSP + WS_US, WSP + WS_WIN + (size_t)l * NPROJ * D, MT, NPROJ, D}; pg8::StaticOrder S; S.init(MT, NPROJ, G, wg);
            pg8::EpiInProjI8 E{Pb, LDP, pg8::LdsScales{(const float*)(WSP + WS_SA), (const float*)(WSP + WS_SBIN) + l * NPROJ, lds}};
            pg8::gemm_phase<pg8::EpiInProjI8, pg8::StaticOrder, 2>(lds, g, S, E);
        } SEAM(2 + pb);
        if (IN(3 + pb)) { phase_gla_local(KA(), l, lds); phase_conv(KA(), l); } SEAM(3 + pb);
        if (IN(4 + pb)) { phase_gla_scan(KA()); } SEAM(4 + pb);
        if (IN(5 + pb)) { phase_gla_out(KA(), l, lds); } SEAM(5 + pb);
        if (IN(6 + pb)) {
            const int M = l == 0 ? MT : ML;
            pg8::Gemm g{Hb, (const bf16*)(WSP + WS_WOUT) + (size_t)l * D * D, M, D, D}; pg8::StaticOrder S; S.init(M, D, G, wg);
            pg8::EpiPlain E{Pb, D};
            pg8::gemm_phase<pg8::EpiPlain, pg8::StaticOrder>(lds, g, S, E);
            if (l == 0) {
                const int nwgu = (MT / 256) * (D / 256), nfull = nwgu % G;
                __syncthreads();
                if (nfull == 0) convert_expert_weights(KA(), lds, wg * NWAVES + wave, G * NWAVES, 1);
                else if (wg >= nfull) convert_expert_weights(KA(), lds, (wg - nfull) * NWAVES + wave, (G - nfull) * NWAVES, 1); }
        } SEAM(6 + pb);
        if (IN(7 + pb)) { if (l == 0) phase_postmix<0>(KA(), lds); else phase_postmix<1>(KA(), lds); } SEAM(7 + pb);
        if (l == 0) {
            if (IN(8)) {
                pg8::Gemm g{Hb, WSP + WS_W13, MT, 2 * DFF, D}; pg8::StaticOrder S; S.init(MT, 2 * DFF, G, wg);
                pg8::EpiPairI8<1> E{Pb, DFF, pg8::LdsScales{(const float*)(WSP + WS_SA), (const float*)(WSP + WS_SB13), lds}};
                pg8::gemm_phase<pg8::EpiPairI8<1>, pg8::StaticOrder, 2>(lds, g, S, E);
            } SEAM(8);
            if (IN(9)) {
                pg8::Gemm g{Pb, WSP + WS_W2, MT, D, DFF}; pg8::StaticOrder S; S.init(MT, D, G, wg);
                pg8::EpiPlain E{Hb, D, 1.0f / W2_SCALE};
                pg8::gemm_phase<pg8::EpiPlain, pg8::StaticOrder, 1>(lds, g, S, E);
                { const int nwgu = (MT / 256) * (D / 256), nfull = nwgu % G;
                  __syncthreads();
                  if (nfull == 0) convert_expert_weights(KA(), lds, wg * NWAVES + wave, G * NWAVES, 0);
                  else if (wg >= nfull) convert_expert_weights(KA(), lds, (wg - nfull) * NWAVES + wave, (G - nfull) * NWAVES, 0); }
            } SEAM(9);
            if (IN(10)) { phase_postffn0(KA()); } SEAM(10);
        }
    }
    if (IN(17)) { phase_gather(KA()); } SEAM(17);
    {
        unsigned cnt[8], off[9];
        const unsigned* ecnt = (const unsigned*)(WSP + WS_CTL) + CW_ECNT;
        if (hi > 18) {
#pragma unroll
            for (int e = 0; e < 8; ++e) cnt[e] = __hip_atomic_load(ecnt + e, __ATOMIC_RELAXED, __HIP_MEMORY_SCOPE_AGENT);
            expert_offsets(cnt, off);
        } else off[8] = 0u;
        const int ntiles = (int)(off[8] >> 8);
        for (int grp = 0; grp < MAXGROUPS; ++grp) {
            const int t0 = grp * GROUP_TILES; int nt = ntiles - t0; nt = nt > GROUP_TILES ? GROUP_TILES : nt;
            if (IN(18 + 2 * grp) && nt > 0) {
                pg8::Gemm g{WSP + WS_GATH + (size_t)t0 * 256 * D, WSP + WS_E13, nt * 256, 2 * DFFE, D};
                pg8::MoeOrder S; S.init(nt * 256, 2 * DFFE, G, wg); S.t0 = t0; for (int q = 0; q < 8; ++q) S.toff[q] = (int)(off[q] >> 8); S.ebytes = (size_t)2 * DFFE * D;
                pg8::EpiPairF8 E{WSP + WS_HID_MOE, DFFE, 1.0f / W13_SCALE};
                pg8::gemm_phase<pg8::EpiPairF8, pg8::MoeOrder, 1>(lds, g, S, E);
            } if (nt > 0) SEAM(18 + 2 * grp);
            if (IN(19 + 2 * grp) && nt > 0) {
                pg8::Gemm g{WSP + WS_HID_MOE, WSP + WS_E2, nt * 256, D, DFFE};
                pg8::MoeOrder S; S.init(nt * 256, D, G, wg); S.t0 = t0; for (int q = 0; q < 8; ++q) S.toff[q] = (int)(off[q] >> 8); S.ebytes = (size_t)D * DFFE;
                pg8::EpiPlainF8 E{WSP + WS_YSLOT + (size_t)t0 * 256 * D, D, 1.0f / W2_SCALE};
                pg8::gemm_phase<pg8::EpiPlainF8, pg8::MoeOrder, 1>(lds, g, S, E);
            } if (nt > 0) SEAM(19 + 2 * grp);
        }
    }
    if (IN(28)) { phase_final(KA()); } SEAM(28);
#undef Hb
#undef Pb
#undef WSP
#undef IN
#undef SEAM
}

extern "C" void kernel_launch(void* const* d_in, const int* in_sizes, int n_in, void* d_out, int out_size, void* d_ws, size_t ws_size, hipStream_t stream) {
    static int grid = 0;
    if (grid == 0) {
        if (n_in != 23 || out_size != ML * D || ws_size < WS_END) { fprintf(stderr, "kernel_launch: unexpected problem (n_in %d, out %d, ws %zu < %zu)\n", n_in, out_size, ws_size, (size_t)WS_END); grid = -1; return; }
        int dev = 0, cus = 0, per_cu = 0;
        if (hipGetDevice(&dev) != hipSuccess || hipDeviceGetAttribute(&cus, hipDeviceAttributeMultiprocessorCount, dev) != hipSuccess) { grid = -1; return; }
        if (hipFuncSetAttribute((const void*)mk_fwd, hipFuncAttributeMaxDynamicSharedMemorySize, LDS_BYTES) != hipSuccess) { fprintf(stderr, "kernel_launch: hipFuncSetAttribute failed\n"); grid = -1; return; }
        if (hipOccupancyMaxActiveBlocksPerMultiprocessor(&per_cu, (const void*)mk_fwd, NTHR, LDS_BYTES) != hipSuccess || per_cu < 1) { fprintf(stderr, "kernel_launch: occupancy query says %d\n", per_cu); }
        (void)hipGetLastError();
        grid = cus;
    }
    if (grid < 0) return;
    hipMemsetAsync((char*)d_ws + WS_CTL, 0, CTL_ZERO_BYTES, stream);
    Args a{};
    for (int i = 0; i < 23; ++i) a.in[i] = (const float*)d_in[i];
    a.out = (float*)d_out; a.ws = (unsigned char*)d_ws;
#if MK_PER_PHASE
    for (int p = 0; p < NPHASE; ++p) { a.ph_lo = p; a.ph_hi = p + 1; hipLaunchKernelGGL(mk_fwd, dim3(grid), dim3(NTHR), LDS_BYTES, stream, a); }
#else
    a.ph_lo = 0; a.ph_hi = NPHASE; hipLaunchKernelGGL(mk_fwd, dim3(grid), dim3(NTHR), LDS_BYTES, stream, a);
#endif
}
```
